# Optimizing an MI355X kernel written in HIP

```python
import math
import jax, jax.numpy as jnp
from jax import lax
import numpy as np

D_MODEL = 2048
BATCH = 1
SEQ = 16384
DEPTH = 1

HEAD_DIM = 128
N_Q_HEADS = 16
N_KV_HEADS = 4
Q_PER_KV = N_Q_HEADS // N_KV_HEADS
ATTN_WIDTH = N_Q_HEADS * HEAD_DIM
KV_WIDTH = N_KV_HEADS * HEAD_DIM
WINDOW = 128
BLOCK = 128
POOL_WINDOWS = (2, 4, 8, 16)
N_POOL_GROUPS = len(POOL_WINDOWS)
POOL_GROUP_DIM = 256
POOL_WIDTH = N_POOL_GROUPS * POOL_GROUP_DIM
D_FF = 5632
ALPHA = (2.0 * DEPTH) ** 0.25
BETA = (8.0 * DEPTH) ** -0.25
LN_EPS = 1e-5
NEG_INF = -1e30
IN_WIDTH = ATTN_WIDTH + 2 * KV_WIDTH + POOL_WIDTH + 2 * D_MODEL

kernel_name = "hybrid_swa_pool_macaron_deepnorm"


def layer_norm(x, g, b):
    xf = x.astype(jnp.float32)
    mu = jnp.mean(xf, axis=-1, keepdims=True)
    xc = xf - mu
    var = jnp.mean(xc * xc, axis=-1, keepdims=True)
    y = xc * lax.rsqrt(var + LN_EPS)
    return (y * g.astype(jnp.float32) + b.astype(jnp.float32)).astype(x.dtype)


def swiglu(x, w_gate, w_up, w_down):
    return (jax.nn.silu(x @ w_gate) * (x @ w_up)) @ w_down


def alibi_slopes(n_heads):
    return jnp.exp2(-8.0 * jnp.arange(1, n_heads + 1, dtype=jnp.float32) / n_heads)


def banded_gqa_attention(q, k, v, sink):
    B, S = q.shape[0], q.shape[1]
    nb = S // BLOCK
    qb = q.reshape(B, nb, BLOCK, N_KV_HEADS, Q_PER_KV, HEAD_DIM)
    pad = ((0, 0), (BLOCK, BLOCK), (0, 0), (0, 0))
    kp = jnp.pad(k, pad).reshape(B, nb + 2, BLOCK, N_KV_HEADS, HEAD_DIM)
    vp = jnp.pad(v, pad).reshape(B, nb + 2, BLOCK, N_KV_HEADS, HEAD_DIM)
    kb = jnp.concatenate([kp[:, :-2], kp[:, 1:-1], kp[:, 2:]], axis=2)
    vb = jnp.concatenate([vp[:, :-2], vp[:, 1:-1], vp[:, 2:]], axis=2)
    scale = 1.0 / math.sqrt(HEAD_DIM)
    scores = jnp.einsum('bnqhgd,bnkhd->bnhgqk', qb, kb,
                        preferred_element_type=jnp.float32) * scale
    a = jnp.arange(BLOCK)[:, None]
    c = jnp.arange(3 * BLOCK)[None, :]
    dist = jnp.abs(a + BLOCK - c)
    slopes = alibi_slopes(N_Q_HEADS).reshape(N_KV_HEADS, Q_PER_KV)
    bias = -slopes[:, :, None, None] * dist.astype(jnp.float32)[None, None]
    k_pos = (jnp.arange(nb)[:, None] - 1) * BLOCK + jnp.arange(3 * BLOCK)[None, :]
    in_range = (k_pos >= 0) & (k_pos < S)
    valid = in_range[:, None, :] & (dist <= WINDOW)[None]
    scores = jnp.where(valid[None, :, None, None], scores + bias[None, None], NEG_INF)
    sink_l = sink.astype(jnp.float32).reshape(N_KV_HEADS, Q_PER_KV)[None, None, :, :, None, None]
    m = jnp.maximum(jnp.max(scores, axis=-1, keepdims=True), sink_l)
    p = jnp.exp(scores - m)
    denom = jnp.sum(p, axis=-1, keepdims=True) + jnp.exp(sink_l - m)
    probs = (p / denom).astype(v.dtype)
    o = jnp.einsum('bnhgqk,bnkhd->bnqhgd', probs, vb)
    return o.reshape(B, S, ATTN_WIDTH)


def multiscale_pool(p, w_groups, scale):
    B, S, _ = p.shape
    pf = p.astype(jnp.float32)
    cs = jnp.concatenate([jnp.zeros((B, 1, POOL_WIDTH), jnp.float32), jnp.cumsum(pf, axis=1)], axis=1)
    t = jnp.arange(S)
    outs = []
    for g, w in enumerate(POOL_WINDOWS):
        lo = jnp.clip(t - w // 2, 0, S)
        hi = jnp.clip(t + w - w // 2, 0, S)
        csg = cs[..., g * POOL_GROUP_DIM:(g + 1) * POOL_GROUP_DIM]
        win_sum = jnp.take(csg, hi, axis=1) - jnp.take(csg, lo, axis=1)
        mean = win_sum / (hi - lo).astype(jnp.float32)[None, :, None]
        outs.append(mean - pf[..., g * POOL_GROUP_DIM:(g + 1) * POOL_GROUP_DIM])
    d = jnp.stack(outs, axis=2).astype(p.dtype)
    mixed = jnp.einsum('bsgc,gcd->bsgd', d, w_groups).reshape(B, S, POOL_WIDTH)
    return mixed * scale


def hybrid_mixer(x, w_in, attn_sink, pool_w_groups, pool_scale, w_proj_attn, w_proj_pool, w_out):
    B, S, _ = x.shape
    h = x @ w_in
    i0 = ATTN_WIDTH
    i1 = i0 + KV_WIDTH
    i2 = i1 + KV_WIDTH
    i3 = i2 + POOL_WIDTH
    i4 = i3 + D_MODEL
    q = h[..., :i0].reshape(B, S, N_Q_HEADS, HEAD_DIM)
    k = h[..., i0:i1].reshape(B, S, N_KV_HEADS, HEAD_DIM)
    v = h[..., i1:i2].reshape(B, S, N_KV_HEADS, HEAD_DIM)
    pb = h[..., i2:i3]
    gate_a = h[..., i3:i4]
    gate_b = h[..., i4:]
    y_a = banded_gqa_attention(q, k, v, attn_sink) @ w_proj_attn
    y_b = multiscale_pool(pb, pool_w_groups, pool_scale) @ w_proj_pool
    merged = jax.nn.sigmoid(gate_a) * y_a + jax.nn.sigmoid(gate_b) * y_b
    return merged @ w_out


def setup_inputs(seed: int = 0) -> dict:
    key = jax.random.key(seed)
    ks = jax.random.split(key, 24)
    f32 = jnp.float32

    def nrm(k, shape, s):
        return jax.random.normal(k, shape, f32) * s

    L = DEPTH
    D = D_MODEL
    return {
        'x': jax.random.normal(ks[0], (BATCH, SEQ, D), f32),
        'ffn1_w_gate': nrm(ks[1], (L, D, D_FF), D ** -0.5),
        'ffn1_w_up': nrm(ks[2], (L, D, D_FF), D ** -0.5),
        'ffn1_w_down': nrm(ks[3], (L, D_FF, D), BETA * D_FF ** -0.5),
        'ln1_g': 1.0 + nrm(ks[4], (L, D), 0.05),
        'ln1_b': nrm(ks[5], (L, D), 0.02),
        'w_in': nrm(ks[6], (L, D, IN_WIDTH), D ** -0.5),
        'attn_sink': nrm(ks[7], (L, N_Q_HEADS), 0.5),
        'pool_w_groups': nrm(ks[8], (L, N_POOL_GROUPS, POOL_GROUP_DIM, POOL_GROUP_DIM), POOL_GROUP_DIM ** -0.5),
        'pool_scale': 1.0 + nrm(ks[9], (L, POOL_WIDTH), 0.1),
        'w_proj_attn': nrm(ks[10], (L, ATTN_WIDTH, D), ATTN_WIDTH ** -0.5),
        'w_proj_pool': nrm(ks[11], (L, POOL_WIDTH, D), POOL_WIDTH ** -0.5),
        'w_out': nrm(ks[12], (L, D, D), BETA * D ** -0.5),
        'ln2_g': 1.0 + nrm(ks[13], (L, D), 0.05),
        'ln2_b': nrm(ks[14], (L, D), 0.02),
        'ffn2_w_gate': nrm(ks[15], (L, D, D_FF), D ** -0.5),
        'ffn2_w_up': nrm(ks[16], (L, D, D_FF), D ** -0.5),
        'ffn2_w_down': nrm(ks[17], (L, D_FF, D), BETA * D_FF ** -0.5),
        'ln3_g': 1.0 + nrm(ks[18], (L, D), 0.05),
        'ln3_b': nrm(ks[19], (L, D), 0.02),
    }


def reference(x, ffn1_w_gate, ffn1_w_up, ffn1_w_down, ln1_g, ln1_b,
              w_in, attn_sink, pool_w_groups, pool_scale, w_proj_attn, w_proj_pool, w_out,
              ln2_g, ln2_b, ffn2_w_gate, ffn2_w_up, ffn2_w_down, ln3_g, ln3_b):
    for l in range(DEPTH):
        x = layer_norm(ALPHA * x + 0.5 * swiglu(x, ffn1_w_gate[l], ffn1_w_up[l], ffn1_w_down[l]),
                       ln1_g[l], ln1_b[l])
        x = layer_norm(ALPHA * x + hybrid_mixer(x, w_in[l], attn_sink[l], pool_w_groups[l], pool_scale[l],
                                                w_proj_attn[l], w_proj_pool[l], w_out[l]),
                       ln2_g[l], ln2_b[l])
        x = layer_norm(ALPHA * x + 0.5 * swiglu(x, ffn2_w_gate[l], ffn2_w_up[l], ffn2_w_down[l]),
                       ln3_g[l], ln3_b[l])
    return x
```

```cpp
#include <hip/hip_runtime.h>
#include <hip/hip_cooperative_groups.h>
#include <cstdio>
#include <cstdint>
namespace cg = cooperative_groups;

namespace pg8 {
#define PG8_LAS __attribute__((address_space(3)))
typedef unsigned short bf16_t;
typedef short bf16x8 __attribute__((ext_vector_type(8)));
typedef float f32x4 __attribute__((ext_vector_type(4)));
typedef unsigned u32x4 __attribute__((ext_vector_type(4)));
constexpr int BM = 256, BK = 64, HALF = 128, HTB = HALF * BK * 2  , STAGE_BYTES = 8 * HTB, NXCD = 8, WGM = 8;

__host__ __device__ __forceinline__ int lds_byte(int r, int c) { const int st = (r >> 4) * 2 + (c >> 5), rr = r & 15, cc = c & 31, ob = rr * 64 + cc * 2; return st * 1024 + (ob ^ (((ob >> 9) & 1) << 5)); }
__host__ __device__ __forceinline__ void stage_rc(int b, int& R, int& C) { const int st = b / 1024, sb = b % 1024, swz = sb ^ (((sb >> 9) & 1) << 5); R = (st >> 1) * 16 + swz / 64; C = (st & 1) * 32 + (swz % 64) / 2; }
__host__ __device__ __forceinline__ int perm32(int rho) { const int n = rho >> 4, i = rho & 15; return 8 * (i >> 2) + 4 * n + (i & 3); }

struct Unit { int pm, pn; };
struct Gemm { const bf16_t* A; const bf16_t* Bt; int K, lda, ldb, acol_pn; };

struct StaticOrder {
    int nM, nN, nwg, G, c;
    __host__ __device__ void init(int M, int N, int G_, int c_) { nM = M / BM; nN = N / BM; nwg = nM * nN; G = G_; c = c_; }
    __host__ __device__ bool next(int i, Unit& u) const {
        const long L = (long)i * G + c; if (L >= nwg) return false;
        int wgid = (int)L; { const int q = nwg / NXCD, r = nwg % NXCD, xcd = wgid % NXCD, off = wgid / NXCD; wgid = (xcd < r ? xcd * (q + 1) : r * (q + 1) + (xcd - r) * q) + off; }
        const int nig = WGM * nN, gid = wgid / nig, fm = gid * WGM, gsz = (nM - fm) < WGM ? (nM - fm) : WGM;
        u.pm = fm + ((wgid % nig) % gsz); u.pn = (wgid % nig) / gsz; return true;
    }
    __device__ __forceinline__ void a_ready(const Unit&) const {}
    __device__ __forceinline__ void done(const Unit&) const {}
};


__device__ __forceinline__ unsigned cvt_pk_bf16(float lo, float hi) { unsigned r; asm volatile("v_cvt_pk_bf16_f32 %0, %1, %2" : "=v"(r) : "v"(lo), "v"(hi)); return r; }
__device__ __forceinline__ float sigm(float v) { return __builtin_amdgcn_rcpf(1.f + __builtin_amdgcn_exp2f(-1.4426950408889634f * v)); }
__device__ __forceinline__ float bf_lo(unsigned w) { return __uint_as_float(w << 16); }
__device__ __forceinline__ float bf_hi(unsigned w) { return __uint_as_float(w & 0xffff0000u); }
__device__ __forceinline__ u32x4 pack8(const f32x4 v0, const f32x4 v1) { u32x4 w; w.x = cvt_pk_bf16(v0[0], v0[1]); w.y = cvt_pk_bf16(v0[2], v0[3]); w.z = cvt_pk_bf16(v1[0], v1[1]); w.w = cvt_pk_bf16(v1[2], v1[3]); return w; }
__device__ __forceinline__ void unpack8(const u32x4 w, f32x4& v0, f32x4& v1) { v0 = (f32x4){bf_lo(w.x), bf_hi(w.x), bf_lo(w.y), bf_hi(w.y)}; v1 = (f32x4){bf_lo(w.z), bf_hi(w.z), bf_lo(w.w), bf_hi(w.w)}; }

struct EpiSwiGLU {
    static constexpr bool PERM = true, AFTER_DRAIN = false;
    bf16_t* O; int ldc;
    __device__ __forceinline__ void operator()(const f32x4 (&acc)[2][2][4][2], const Unit& u, int wr, int wc, int fr, int fq) const {
        const int row0 = u.pm * BM + wr * 64 + fr, col0 = u.pn * HALF + wc * 32 + 8 * fq;
#pragma unroll
        for (int ai = 0; ai < 2; ++ai)
#pragma unroll
            for (int m = 0; m < 4; ++m) { bf16_t* rowp = O + (size_t)(row0 + ai * HALF + m * 16) * ldc + col0;
                f32x4 h0, h1;
#pragma unroll
                for (int j = 0; j < 4; ++j) { const float g0 = acc[ai][0][m][0][j], g1 = acc[ai][0][m][1][j];
                    h0[j] = g0 * sigm(g0) * acc[ai][1][m][0][j]; h1[j] = g1 * sigm(g1) * acc[ai][1][m][1][j]; }
                *(u32x4*)rowp = pack8(h0, h1); }
    }
};
struct EpiBf16Sig {
    static constexpr bool PERM = true, AFTER_DRAIN = false;
    bf16_t* O; int ldc; int sig_from;
    __device__ __forceinline__ void operator()(const f32x4 (&acc)[2][2][4][2], const Unit& u, int wr, int wc, int fr, int fq) const {
        const int row0 = u.pm * BM + wr * 64 + fr, col0 = u.pn * BM + wc * 32 + 8 * fq; const bool sg = u.pn >= sig_from;
#pragma unroll
        for (int ai = 0; ai < 2; ++ai)
#pragma unroll
            for (int m = 0; m < 4; ++m) { bf16_t* rowp = O + (size_t)(row0 + ai * HALF + m * 16) * ldc + col0;
#pragma unroll
                for (int bj = 0; bj < 2; ++bj) { f32x4 v0 = acc[ai][bj][m][0], v1 = acc[ai][bj][m][1];
                    if (sg) {
#pragma unroll
                        for (int j = 0; j < 4; ++j) { v0[j] = sigm(v0[j]); v1[j] = sigm(v1[j]); } }
                    *(u32x4*)(rowp + bj * HALF) = pack8(v0, v1); } }
    }
};
struct EpiColScale {
    static constexpr bool PERM = true, AFTER_DRAIN = false;
    bf16_t* O; int ldc; const float* scale;
    __device__ __forceinline__ void operator()(const f32x4 (&acc)[2][2][4][2], const Unit& u, int wr, int wc, int fr, int fq) const {
        const int row0 = u.pm * BM + wr * 64 + fr, col0 = u.pn * BM + wc * 32 + 8 * fq;
        f32x4 sv[2][2];
#pragma unroll
        for (int bj = 0; bj < 2; ++bj)
#pragma unroll
            for (int n = 0; n < 2; ++n) sv[bj][n] = *(const f32x4*)(scale + col0 + bj * HALF + 4 * n);
#pragma unroll
        for (int ai = 0; ai < 2; ++ai)
#pragma unroll
            for (int m = 0; m < 4; ++m) { bf16_t* rowp = O + (size_t)(row0 + ai * HALF + m * 16) * ldc + col0;
#pragma unroll
                for (int bj = 0; bj < 2; ++bj) *(u32x4*)(rowp + bj * HALF) = pack8(acc[ai][bj][m][0] * sv[bj][0], acc[ai][bj][m][1] * sv[bj][1]); }
    }
};
template <bool ADD> struct EpiGate {
    static constexpr bool PERM = true, AFTER_DRAIN = false;
    bf16_t* O; int ldc; const bf16_t* G; int ldg;
    __device__ __forceinline__ void operator()(const f32x4 (&acc)[2][2][4][2], const Unit& u, int wr, int wc, int fr, int fq) const {
        const int row0 = u.pm * BM + wr * 64 + fr, col0 = u.pn * BM + wc * 32 + 8 * fq;
#pragma unroll
        for (int ai = 0; ai < 2; ++ai)
#pragma unroll
            for (int m = 0; m < 4; ++m) { const size_t r = (size_t)(row0 + ai * HALF + m * 16); bf16_t* rowp = O + r * ldc + col0; const bf16_t* gp = G + r * ldg + col0;
#pragma unroll
                for (int bj = 0; bj < 2; ++bj) { f32x4 g0, g1; unpack8(*(const u32x4*)(gp + bj * HALF), g0, g1);
                    f32x4 v0 = acc[ai][bj][m][0] * g0, v1 = acc[ai][bj][m][1] * g1;
                    if (ADD) { f32x4 t0, t1; unpack8(*(const u32x4*)(rowp + bj * HALF), t0, t1); v0 += t0; v1 += t1; }
                    *(u32x4*)(rowp + bj * HALF) = pack8(v0, v1); }
                asm volatile("" ::: "memory"); }
    }
};
struct EpiResF32 {
    static constexpr bool PERM = false, AFTER_DRAIN = false;
    const float* res; float* out; int ldc; float ra, sa;
    __device__ __forceinline__ void operator()(const f32x4 (&acc)[2][2][4][2], const Unit& u, int wr, int wc, int fr, int fq) const {
        const int col0 = u.pn * BM + wc * 32 + 4 * fq;
#pragma unroll
        for (int ai = 0; ai < 2; ++ai)
#pragma unroll
            for (int m = 0; m < 4; ++m) { const size_t off = (size_t)(u.pm * BM + ai * HALF + wr * 64 + m * 16 + fr) * ldc + col0;
#pragma unroll
                for (int bj = 0; bj < 2; ++bj)
#pragma unroll
                    for (int n = 0; n < 2; ++n) { const f32x4 bs = *(const f32x4*)(res + off + bj * HALF + n * 16);
                        *(f32x4*)(out + off + bj * HALF + n * 16) = bs * ra + acc[ai][bj][m][n] * sa; }
                asm volatile("" ::: "memory"); }
    }
};

template <class Epi, class Sched, bool ALIGN_EPI = false, bool SP2 = false>
__device__ __forceinline__ void gemm_phase(PG8_LAS unsigned char* lds, const Gemm g, const Sched& S, const Epi& E) {
    int tid = threadIdx.x; asm volatile("" : "+v"(tid)); const int wid = __builtin_amdgcn_readfirstlane(tid >> 6), lane = tid & 63, wr = wid >> 2, wc = wid & 3, fr = lane & 15, fq = lane >> 4;
    const int K = g.K, nt = K / BK;
    unsigned voffA[2], voffB[2];
#pragma unroll
    for (int i = 0; i < 2; ++i) { int R, C; stage_rc(tid * 16 + i * 8192, R, C); const int Rb = Epi::PERM ? ((R & ~31) + perm32(R & 31)) : R;
        voffA[i] = (unsigned)(R * g.lda + C) * 2u; voffB[i] = (unsigned)(Rb * g.ldb + C) * 2u; }
    const size_t kstep = (size_t)(BK * 2);
    const size_t hstepA = (size_t)HALF * g.lda * 2, hstepB = (size_t)HALF * g.ldb * 2;
    const size_t tstepA = 2 * hstepA, tstepB = 2 * hstepB, pnA = (size_t)g.acol_pn * 2;
    const unsigned ldsw = (unsigned)wid * 1024u;
    const int aoff = lds_byte(wr * 64 + fr, fq * 8), boff = lds_byte(wc * 32 + fr, fq * 8);
#define PG8_SA(b, h) (((b) * 2 + (h)) * HTB)
#define PG8_SB(b, h) ((4 + (b) * 2 + (h)) * HTB)
#define PG8_STAGE(bufoff, gbase, voff) do { _Pragma("unroll") for (int _i = 0; _i < 2; ++_i) \
        __builtin_amdgcn_global_load_lds((const unsigned*)((const char*)(gbase) + (voff)[_i]), (PG8_LAS unsigned*)(lds + (bufoff) + ldsw + _i * 8192), 16, 0, 0); } while (0)
#define PG8_LDA(dst, b, h) do { _Pragma("unroll") for (int m = 0; m < 4; ++m) _Pragma("unroll") for (int k = 0; k < 2; ++k) dst[m][k] = *(const PG8_LAS bf16x8*)(lds + PG8_SA(b, h) + aoff + m * 2048 + k * 1024); } while (0)
#define PG8_LDB(dst, b, h) do { _Pragma("unroll") for (int n = 0; n < 2; ++n) _Pragma("unroll") for (int k = 0; k < 2; ++k) dst[n][k] = *(const PG8_LAS bf16x8*)(lds + PG8_SB(b, h) + boff + n * 2048 + k * 1024); } while (0)
#define PG8_MMA(ai, bj, At, Bt) do { __builtin_amdgcn_s_setprio(1); _Pragma("unroll") for (int m = 0; m < 4; ++m) _Pragma("unroll") for (int n = 0; n < 2; ++n) _Pragma("unroll") for (int k = 0; k < 2; ++k) \
        acc[ai][bj][m][n] = __builtin_amdgcn_mfma_f32_16x16x32_bf16(Bt[n][k], At[m][k], acc[ai][bj][m][n], 0, 0, 0); __builtin_amdgcn_s_setprio(0); } while (0)
#define PG8_WAIT_V(n) asm volatile("s_waitcnt vmcnt(" #n ")" ::: "memory")
#define PG8_WAIT_L(n) asm volatile("s_waitcnt lgkmcnt(" #n ")" ::: "memory")
#define PG8_BAR __builtin_amdgcn_s_barrier()
#define PG8_SCHED __builtin_amdgcn_sched_barrier(0)
    Unit cur, nxt; int ui = 0;
    if (!S.next(0, cur)) return;
    f32x4 acc[2][2][4][2];
#pragma unroll
    for (int a = 0; a < 2; ++a)
#pragma unroll
        for (int b = 0; b < 2; ++b)
#pragma unroll
            for (int m = 0; m < 4; ++m)
#pragma unroll
                for (int n = 0; n < 2; ++n) acc[a][b][m][n] = (f32x4){0.f, 0.f, 0.f, 0.f};
    bf16x8 At[4][2], B0[2][2], B1[2][2];
    const char* cA = (const char*)g.A + (size_t)cur.pm * tstepA + (size_t)cur.pn * pnA; const char* cB = (const char*)g.Bt + (size_t)cur.pn * tstepB;
    S.a_ready(cur);
    if constexpr (SP2) {
        PG8_STAGE(PG8_SB(0, 0), cB, voffB); PG8_STAGE(PG8_SB(0, 1), cB + hstepB, voffB); PG8_STAGE(PG8_SA(0, 0), cA, voffA); PG8_STAGE(PG8_SA(0, 1), cA + hstepA, voffA);
        if (wr == 1) PG8_BAR;
        PG8_WAIT_V(2); PG8_BAR;
        PG8_STAGE(PG8_SB(1, 0), cB + kstep, voffB); PG8_STAGE(PG8_SA(1, 0), cA + kstep, voffA); PG8_STAGE(PG8_SB(1, 1), cB + hstepB + kstep, voffB);
        PG8_WAIT_V(6); PG8_BAR;
    } else {
        PG8_STAGE(PG8_SB(0, 0), cB, voffB); PG8_STAGE(PG8_SA(0, 0), cA, voffA); PG8_STAGE(PG8_SB(0, 1), cB + hstepB, voffB); PG8_STAGE(PG8_SA(0, 1), cA + hstepA, voffA);
        if (wr == 1) PG8_BAR;
        PG8_WAIT_V(4); PG8_BAR;
        PG8_STAGE(PG8_SB(1, 0), cB + kstep, voffB); PG8_STAGE(PG8_SA(1, 0), cA + kstep, voffA); PG8_STAGE(PG8_SB(1, 1), cB + hstepB + kstep, voffB);
        PG8_WAIT_V(6); PG8_BAR;
    }
    for (;;) {
        const bool has_next = S.next(ui + 1, nxt);
        const char* nA = has_next ? (const char*)g.A + (size_t)nxt.pm * tstepA + (size_t)nxt.pn * pnA : cA; const char* nB = has_next ? (const char*)g.Bt + (size_t)nxt.pn * tstepB : cB;
        for (int t = 0; t < nt; t += 2) {
            const bool last = (t == nt - 2);
            const char* a1 = cA + (size_t)(t + 1) * kstep;
            const char* a2 = last ? nA : cA + (size_t)(t + 2) * kstep; const char* b2 = last ? nB : cB + (size_t)(t + 2) * kstep;
            const char* a3 = a2 + kstep; const char* b3 = b2 + kstep;
            if (last && has_next) S.a_ready(nxt);
            if constexpr (SP2) {
            PG8_LDB(B0, 0, 0); PG8_LDB(B1, 0, 1); PG8_SCHED; PG8_LDA(At, 0, 0); PG8_STAGE(PG8_SA(1, 1), a1 + hstepA, voffA);
            PG8_WAIT_V(8); PG8_WAIT_L(0); PG8_BAR; PG8_MMA(0, 0, At, B0); PG8_MMA(0, 1, At, B1); PG8_BAR; PG8_SCHED;
            PG8_LDA(At, 0, 1); PG8_STAGE(PG8_SB(0, 0), b2, voffB); PG8_STAGE(PG8_SB(0, 1), b2 + hstepB, voffB); PG8_STAGE(PG8_SA(0, 0), a2, voffA);
            PG8_WAIT_V(8); PG8_WAIT_L(0); PG8_BAR; PG8_MMA(1, 0, At, B0); PG8_MMA(1, 1, At, B1); PG8_BAR; PG8_SCHED;
            PG8_LDB(B0, 1, 0); PG8_LDB(B1, 1, 1); PG8_SCHED; PG8_LDA(At, 1, 0); PG8_STAGE(PG8_SA(0, 1), a2 + hstepA, voffA);
            PG8_WAIT_V(8); PG8_WAIT_L(0); PG8_BAR; PG8_MMA(0, 0, At, B0); PG8_MMA(0, 1, At, B1); PG8_BAR; PG8_SCHED;
            PG8_LDA(At, 1, 1); PG8_STAGE(PG8_SB(1, 0), b3, voffB); PG8_STAGE(PG8_SB(1, 1), b3 + hstepB, voffB); PG8_STAGE(PG8_SA(1, 0), a3, voffA);
            PG8_WAIT_V(8); PG8_WAIT_L(0); PG8_BAR; PG8_MMA(1, 0, At, B0); PG8_MMA(1, 1, At, B1); PG8_BAR; PG8_SCHED;
            } else {
            PG8_LDB(B0, 0, 0); PG8_SCHED; PG8_LDA(At, 0, 0); PG8_STAGE(PG8_SA(1, 1), a1 + hstepA, voffA);
            PG8_WAIT_L(8); PG8_BAR; PG8_WAIT_L(0); PG8_MMA(0, 0, At, B0); PG8_BAR; PG8_SCHED;
            PG8_LDB(B1, 0, 1); PG8_STAGE(PG8_SB(0, 0), b2, voffB);
            PG8_BAR; PG8_WAIT_L(0); PG8_MMA(0, 1, At, B1); PG8_BAR;
            PG8_LDA(At, 0, 1); PG8_STAGE(PG8_SA(0, 0), a2, voffA);
            PG8_BAR; PG8_WAIT_L(0); PG8_MMA(1, 0, At, B0); PG8_BAR; PG8_SCHED;
            PG8_STAGE(PG8_SB(0, 1), b2 + hstepB, voffB);
            PG8_WAIT_V(6); PG8_BAR; PG8_MMA(1, 1, At, B1); PG8_BAR;
            PG8_LDB(B0, 1, 0); PG8_SCHED; PG8_LDA(At, 1, 0); PG8_STAGE(PG8_SA(0, 1), a2 + hstepA, voffA);
            PG8_WAIT_L(8); PG8_BAR; PG8_WAIT_L(0); PG8_MMA(0, 0, At, B0); PG8_BAR; PG8_SCHED;
            PG8_LDB(B1, 1, 1); PG8_STAGE(PG8_SB(1, 0), b3, voffB);
            PG8_BAR; PG8_WAIT_L(0); PG8_MMA(0, 1, At, B1); PG8_BAR;
            PG8_LDA(At, 1, 1); PG8_STAGE(PG8_SA(1, 0), a3, voffA);
            PG8_BAR; PG8_WAIT_L(0); PG8_MMA(1, 0, At, B0); PG8_BAR; PG8_SCHED;
            PG8_STAGE(PG8_SB(1, 1), b3 + hstepB, voffB);
            PG8_WAIT_V(6); PG8_BAR; PG8_MMA(1, 1, At, B1); PG8_BAR;
            }
        }
        if constexpr (ALIGN_EPI) { if (wr == 0) PG8_BAR; }
        if constexpr (!Epi::AFTER_DRAIN) { E(acc, cur, wr, wc, fr, fq); S.done(cur); }
        if (!has_next) break;
#pragma unroll
        for (int a = 0; a < 2; ++a)
#pragma unroll
            for (int b = 0; b < 2; ++b)
#pragma unroll
                for (int m = 0; m < 4; ++m)
#pragma unroll
                    for (int n = 0; n < 2; ++n) acc[a][b][m][n] = (f32x4){0.f, 0.f, 0.f, 0.f};
        cur = nxt; cA = nA; cB = nB; ++ui;
        if constexpr (ALIGN_EPI) { if (wr == 1) PG8_BAR; }
    }
    PG8_WAIT_V(0);
    if constexpr (!ALIGN_EPI) { if (wr == 0) PG8_BAR; }
    PG8_BAR;
    if constexpr (Epi::AFTER_DRAIN) { E.fused(acc, cur, wr, wc, fr, fq, lds, wid, lane); S.done(cur); }
#undef PG8_SA
#undef PG8_SB
#undef PG8_STAGE
#undef PG8_LDA
#undef PG8_LDB
#undef PG8_MMA
#undef PG8_WAIT_V
#undef PG8_WAIT_L
#undef PG8_BAR
#undef PG8_SCHED
}
}

#define LAS __attribute__((address_space(3)))
typedef unsigned short bf16_t;
typedef float f32x4 __attribute__((ext_vector_type(4)));
typedef unsigned u32x4 __attribute__((ext_vector_type(4)));
constexpr int M = 16384, DM = 2048, FF = 5632, INW = 8192, SEQ = 16384;
constexpr int NQH = 16, NKVH = 4, HD = 128;
constexpr int COL_K = 2048, COL_V = 2560, COL_P = 3072, COL_GA = 4096, COL_GB = 6144;
constexpr float ALPHA = 1.189207115002721f;
constexpr float LN_EPS = 1e-5f;

namespace att {
using bf16x8 = __attribute__((ext_vector_type(8))) short;
using s16x4  = __attribute__((ext_vector_type(4))) short;
using f32x16 = __attribute__((ext_vector_type(16))) float;
#define KSWZ(row, colB) ((row) * 256 + ((colB) ^ (((row) & 7) << 4)))
#define SBAR() __builtin_amdgcn_sched_barrier(0)
__device__ __forceinline__ int crow(int r, int hi) { return (r & 3) + 8 * (r >> 2) + 4 * hi; }
__device__ __forceinline__ unsigned cvtpk(float lo, float hi) { unsigned r; asm volatile("v_cvt_pk_bf16_f32 %0, %1, %2" : "=v"(r) : "v"(lo), "v"(hi)); return r; }
__device__ __forceinline__ int v_st(int k, int c) { const int kk = (k & ~0xC) | ((k & 4) << 1) | ((k & 8) >> 1); return ((kk >> 3) * 4 + (c >> 5)) * 512 + ((kk & 7) * 32 + (c & 31)) * 2; }
__device__ __forceinline__ int v_rd_base(int lane) { return ((lane & 3) << 3) | (((lane >> 2) & 3) << 6) | (((lane >> 4) & 1) << 5) | (((lane >> 5) & 1) << 8); }
constexpr int v_rd_off(int d0, int ks, int half) { return d0 * 512 + ks * 4096 + half * 2048; }
template <int OFF> __device__ __forceinline__ s16x4 tr_read(int vb) {
  s16x4 r; asm volatile("ds_read_b64_tr_b16 %0, %1 offset:%2" : "=&v"(r) : "v"(vb), "i"(OFF) : "memory"); return r;
}
template <int D0> __device__ __forceinline__ void pv_one(f32x16& od, int vb, bf16x8 pa0, bf16x8 pa1, bf16x8 pa2, bf16x8 pa3) {
  const s16x4 l0 = tr_read<v_rd_off(D0, 0, 0)>(vb), h0 = tr_read<v_rd_off(D0, 0, 1)>(vb), l1 = tr_read<v_rd_off(D0, 1, 0)>(vb), h1 = tr_read<v_rd_off(D0, 1, 1)>(vb);
  const s16x4 l2 = tr_read<v_rd_off(D0, 2, 0)>(vb), h2 = tr_read<v_rd_off(D0, 2, 1)>(vb), l3 = tr_read<v_rd_off(D0, 3, 0)>(vb), h3 = tr_read<v_rd_off(D0, 3, 1)>(vb);
  asm volatile("s_waitcnt lgkmcnt(0)" ::: "memory"); SBAR();
#define PK(L, H) (bf16x8){L[0], L[1], L[2], L[3], H[0], H[1], H[2], H[3]}
  od = __builtin_amdgcn_mfma_f32_32x32x16_bf16(pa0, PK(l0, h0), od, 0, 0, 0);
  od = __builtin_amdgcn_mfma_f32_32x32x16_bf16(pa1, PK(l1, h1), od, 0, 0, 0);
  od = __builtin_amdgcn_mfma_f32_32x32x16_bf16(pa2, PK(l2, h2), od, 0, 0, 0);
  od = __builtin_amdgcn_mfma_f32_32x32x16_bf16(pa3, PK(l3, h3), od, 0, 0, 0);
#undef PK
}
__device__ __forceinline__ void qkt(f32x16& p0, f32x16& p1, const LAS char* Ks, const bf16x8* qr, int r32, int hi) {
  p0 = f32x16{}; p1 = f32x16{};
#pragma unroll
  for (int d0 = 0; d0 < 8; ++d0) { const int cb = (d0 * 16 + hi * 8) * 2;
    const bf16x8 b0 = *(const LAS bf16x8*)(Ks + KSWZ(r32, cb));
    const bf16x8 b1 = *(const LAS bf16x8*)(Ks + KSWZ(32 + r32, cb));
    p0 = __builtin_amdgcn_mfma_f32_32x32x16_bf16(b0, qr[d0], p0, 0, 0, 0);
    p1 = __builtin_amdgcn_mfma_f32_32x32x16_bf16(b1, qr[d0], p1, 0, 0, 0); }
}
constexpr int ATT_LDS = 16384 + 16384 + 8 * 256;

__device__ __forceinline__ void attn_unit(LAS char* lds, bf16_t* HMq, const float* __restrict__ sink, int kvh, int qb) {
  int tid = threadIdx.x; asm volatile("" : "+v"(tid)); const int wid = tid >> 6, lane = tid & 63, r32 = lane & 31, hi = lane >> 5;
  LAS char* V_lds = lds; LAS char* K_lds = lds + 16384;
  LAS float* wsf = (LAS float*)(lds + 32768) + wid * 64; LAS float* al_l = wsf; LAS float* li_l = wsf + 32;
  const int hq = kvh * 4 + (wid >> 1), t0 = qb * 64, trow0 = t0 + 32 * (wid & 1), tq = trow0 + r32;
  constexpr float LOG2E = 1.4426950408889634f, C = 0.088388347648318440f * LOG2E, NEG = -1e30f;
  bf16x8 qr[8];
  { const bf16_t* Qw = HMq + (size_t)tq * INW + hq * HD + hi * 8;
#pragma unroll
    for (int d0 = 0; d0 < 8; ++d0) qr[d0] = *(const bf16x8*)(Qw + d0 * 16); }
  const float slope2 = __builtin_amdgcn_exp2f(-0.5f * (float)(hq + 1)) * LOG2E;
  float m_reg = sink[hq] * LOG2E, l_reg = 1.f;
  f32x16 o[4];
#pragma unroll
  for (int d = 0; d < 4; ++d) o[d] = f32x16{};
  const int sr = tid >> 4, sc = (tid & 15) * 8, vst0 = v_st(sr, sc), vst1 = v_st(32 + sr, sc);
  const int vb0 = (int)(uintptr_t)V_lds + v_rd_base(lane);
  for (int j = 0; j < 5; ++j) {
    const int kbase = t0 - 128 + 64 * j;
    if (kbase < 0 || kbase >= SEQ) continue;
    __syncthreads();
    { const bf16_t* kr0 = HMq + (size_t)(kbase + sr) * INW + COL_K + kvh * HD + sc; const bf16_t* kr1 = kr0 + (size_t)32 * INW;
      const bf16x8 k0v = *(const bf16x8*)kr0, k1v = *(const bf16x8*)kr1, v0v = *(const bf16x8*)(kr0 + (COL_V - COL_K)), v1v = *(const bf16x8*)(kr1 + (COL_V - COL_K));
      *(LAS bf16x8*)(V_lds + vst0) = v0v; *(LAS bf16x8*)(V_lds + vst1) = v1v;
      *(LAS bf16x8*)(K_lds + KSWZ(sr, sc * 2)) = k0v; *(LAS bf16x8*)(K_lds + KSWZ(32 + sr, sc * 2)) = k1v; }
    __syncthreads();
    f32x16 p0, p1;
    qkt(p0, p1, K_lds, qr, r32, hi);
    float pmax = NEG;
#pragma unroll
    for (int r = 0; r < 16; ++r) { const int kp = kbase + crow(r, hi);
      const float d0 = fabsf((float)(tq - kp)), d1 = fabsf((float)(tq - kp - 32));
      const float s0 = fmaf(p0[r], C, -slope2 * d0), s1 = fmaf(p1[r], C, -slope2 * d1);
      p0[r] = d0 <= 128.f ? s0 : NEG; p1[r] = d1 <= 128.f ? s1 : NEG;
      pmax = fmaxf(pmax, fmaxf(p0[r], p1[r])); }
    { auto rr = __builtin_amdgcn_permlane32_swap(__float_as_uint(pmax), __float_as_uint(pmax), false, false);
      pmax = fmaxf(__uint_as_float(rr[0]), __uint_as_float(rr[1])); }
    const float mn = fmaxf(m_reg, pmax), alpha = __builtin_amdgcn_exp2f(m_reg - mn); m_reg = mn;
    float ps = 0.f;
#pragma unroll
    for (int r = 0; r < 16; ++r) { p0[r] = __builtin_amdgcn_exp2f(p0[r] - mn); p1[r] = __builtin_amdgcn_exp2f(p1[r] - mn); ps += p0[r] + p1[r]; }
    { auto rr = __builtin_amdgcn_permlane32_swap(__float_as_uint(ps), __float_as_uint(ps), false, false);
      ps = __uint_as_float(rr[0]) + __uint_as_float(rr[1]); }
    l_reg = l_reg * alpha + ps;
    if (hi == 0) al_l[r32] = alpha;
    asm volatile("s_waitcnt lgkmcnt(0)" ::: "memory");
#pragma unroll
    for (int r = 0; r < 16; ++r) { const float a = al_l[crow(r, hi)];
#pragma unroll
      for (int d = 0; d < 4; ++d) o[d][r] *= a; }
    bf16x8 pa0, pa1, pa2, pa3;
#define PK4(P, BASE, OUT) do { unsigned a0 = cvtpk(P[BASE + 0], P[BASE + 1]), a1 = cvtpk(P[BASE + 2], P[BASE + 3]);   \
    unsigned b0 = cvtpk(P[BASE + 4], P[BASE + 5]), b1 = cvtpk(P[BASE + 6], P[BASE + 7]);                              \
    auto r0 = __builtin_amdgcn_permlane32_swap(a0, b0, false, false); auto r1 = __builtin_amdgcn_permlane32_swap(a1, b1, false, false); \
    u32x4 w = {r0[0], r1[0], r0[1], r1[1]}; OUT = *reinterpret_cast<bf16x8*>(&w); } while (0)
    PK4(p0, 0, pa0); PK4(p0, 8, pa1); PK4(p1, 0, pa2); PK4(p1, 8, pa3);
#undef PK4
    pv_one<0>(o[0], vb0, pa0, pa1, pa2, pa3); pv_one<1>(o[1], vb0, pa0, pa1, pa2, pa3); pv_one<2>(o[2], vb0, pa0, pa1, pa2, pa3); pv_one<3>(o[3], vb0, pa0, pa1, pa2, pa3);
  }
  if (hi == 0) li_l[r32] = l_reg;
  asm volatile("s_waitcnt lgkmcnt(0)" ::: "memory");
  bf16_t* Ow = HMq + (size_t)trow0 * INW + hq * HD + r32;
#pragma unroll
  for (int r = 0; r < 16; ++r) { const int orow = crow(r, hi); const float rl = __builtin_amdgcn_rcpf(li_l[orow]);
#pragma unroll
    for (int d0 = 0; d0 < 4; ++d0) Ow[(size_t)orow * INW + d0 * 32] = (bf16_t)(cvtpk(o[d0][r] * rl, 0.f) & 0xffffu); }
  __syncthreads();
}
}


constexpr size_t MiB = 1u << 20;
constexpr size_t WS_HM = 0;
constexpr size_t WS_WFF = 176 * MiB;
constexpr size_t WS_WM = 256 * MiB;
constexpr size_t WS_XB = 310 * MiB;
constexpr size_t WS_X1 = 374 * MiB;
constexpr size_t WS_END = 502 * MiB;
constexpr size_t OFF_WD = (size_t)2 * FF * DM * 2;
constexpr size_t OFF_WPA = (size_t)INW * DM * 2, OFF_WPP = OFF_WPA + (size_t)DM * DM * 2, OFF_WOUT = OFF_WPP + (size_t)DM * 1024 * 2, OFF_WG = OFF_WOUT + (size_t)DM * DM * 2;
static_assert(WS_WFF + OFF_WD + (size_t)DM * FF * 2 <= WS_WM && (size_t)M * FF * 2 <= WS_WFF && WS_WM + OFF_WG + 1024 * 256 * 2 <= WS_XB, "ws map");

constexpr int NWAVES = 8, NTHREADS = 512;
constexpr int LDS_BYTES = 147456;

__device__ __forceinline__ unsigned f2bf(float f) { unsigned u = __builtin_bit_cast(unsigned, f); return (u + 0x7fffu + ((u >> 16) & 1u)) >> 16; }
__device__ __forceinline__ unsigned pk2(float lo, float hi) { return f2bf(lo) | (f2bf(hi) << 16); }
__device__ __forceinline__ float wave_sum(float v) {
#pragma unroll
    for (int o = 1; o < 64; o <<= 1) v += __shfl_xor(v, o);
    return v;
}
__device__ __forceinline__ void tr_item(const float* __restrict__ W, int K, int N, bf16_t* WT, int mode, int row_off, LAS float* scr, int item, int lane) {
    const int nblk = N >> 6, kb = item / nblk, nb = item - kb * nblk, k0 = kb << 6, n0 = nb << 6;
    const int orow0 = mode == 0 ? row_off + n0 : ((n0 >> 7) << 8) + (n0 & 127) + (mode == 2 ? 128 : 0);
    const int lc = (lane & 15) * 4, lr = lane >> 4;
#pragma unroll 4
    for (int i = 0; i < 16; ++i) { const int k = 4 * i + lr; const f32x4 v = *(const f32x4*)(W + (size_t)(k0 + k) * N + n0 + lc);
        LAS float* s = scr + k * 65 + lc; s[0] = v[0]; s[1] = v[1]; s[2] = v[2]; s[3] = v[3]; }
    asm volatile("s_waitcnt lgkmcnt(0)" ::: "memory");
    const int kc = lane & 7;
#pragma unroll
    for (int j = 0; j < 8; ++j) { const int n = 8 * j + (lane >> 3); const LAS float* s = scr + (8 * kc) * 65 + n;
        u32x4 o; o.x = pk2(s[0 * 65], s[1 * 65]); o.y = pk2(s[2 * 65], s[3 * 65]); o.z = pk2(s[4 * 65], s[5 * 65]); o.w = pk2(s[6 * 65], s[7 * 65]);
        *(u32x4*)(WT + (size_t)(orow0 + n) * K + k0 + 8 * kc) = o; }
    asm volatile("s_waitcnt lgkmcnt(0)" ::: "memory");
}
__device__ __forceinline__ int run_tr(const float* W, bf16_t* WT, int K, int N, int mode, int row_off, int base, int gw, int NGW, LAS float* scr, int lane) {
    const int ni = (K >> 6) * (N >> 6);
    int st = gw - base; if (st < 0) st += NGW;
    for (int it = st; it < ni; it += NGW) tr_item(W, K, N, WT, mode, row_off, scr, it, lane);
    return (base + ni) % NGW;
}

__device__ __forceinline__ void ln_row(const float* zrow, const f32x4 (&gv)[8], const f32x4 (&bv)[8], float* xo, bf16_t* xb, int lane) {
    const f32x4* zr = (const f32x4*)zrow + lane;
    f32x4 v[8]; float s = 0.f;
#pragma unroll
    for (int j = 0; j < 8; ++j) { v[j] = zr[64 * j]; s += (v[j][0] + v[j][1]) + (v[j][2] + v[j][3]); }
    const float mean = wave_sum(s) * (1.f / DM); float s2 = 0.f;
#pragma unroll
    for (int j = 0; j < 8; ++j) { v[j] = v[j] - mean; s2 += (v[j][0] * v[j][0] + v[j][1] * v[j][1]) + (v[j][2] * v[j][2] + v[j][3] * v[j][3]); }
    const float rstd = 1.f / sqrtf(wave_sum(s2) * (1.f / DM) + LN_EPS);
#pragma unroll
    for (int j = 0; j < 8; ++j) { const f32x4 y = v[j] * rstd * gv[j] + bv[j];
        if (xo) ((f32x4*)xo + lane)[64 * j] = y;
        if (xb) ((unsigned long long*)xb + lane)[64 * j] = (unsigned long long)pk2(y[0], y[1]) | ((unsigned long long)pk2(y[2], y[3]) << 32); }
}

struct Args { const float* in[20]; float* out; unsigned char* ws; int ph_lo, ph_hi; };
constexpr int N_PHASES = 13;

__global__ void __launch_bounds__(NTHREADS, 2) fwd_mega(Args args) {
    extern __shared__ __attribute__((aligned(16))) unsigned char lds_raw[];
    LAS unsigned char* lds = (LAS unsigned char*)lds_raw;
    cg::grid_group grid = cg::this_grid();
    const int lo = args.ph_lo, hi = args.ph_hi;
#define IN(k) (lo <= (k) && (k) < hi)
#define SEAM(k) do { if (IN(k) && IN((k) + 1)) grid.sync(); } while (0)
#define PH_BEGIN \
    int tid = threadIdx.x; asm volatile("" : "+v"(tid)); const int lane = tid & 63, wave = __builtin_amdgcn_readfirstlane(tid >> 6); \
    int G = gridDim.x, bid = blockIdx.x; asm volatile("" : "+s"(G), "+s"(bid)); \
    const int gw = bid * NWAVES + wave, NGW = G * NWAVES; const long gtid = (long)bid * NTHREADS + tid, NGT = (long)G * NTHREADS; \
    unsigned char* ws = args.ws; float* out = args.out; asm volatile("" : "+s"(ws), "+s"(out)); \
    bf16_t* HM = (bf16_t*)(ws + WS_HM); bf16_t* Wgu = (bf16_t*)(ws + WS_WFF); bf16_t* Wd = (bf16_t*)(ws + WS_WFF + OFF_WD); \
    bf16_t* WinT = (bf16_t*)(ws + WS_WM); bf16_t* WpaT = (bf16_t*)(ws + WS_WM + OFF_WPA); bf16_t* WppT = (bf16_t*)(ws + WS_WM + OFF_WPP); \
    bf16_t* WoutT = (bf16_t*)(ws + WS_WM + OFF_WOUT); bf16_t* WgT = (bf16_t*)(ws + WS_WM + OFF_WG); \
    bf16_t* XB = (bf16_t*)(ws + WS_XB); float* X1 = (float*)(ws + WS_X1); float* Z2 = (float*)(ws + WS_HM); \
    bf16_t* Dp = (bf16_t*)out; bf16_t* Pm = (bf16_t*)((unsigned char*)out + 32 * MiB); \
    LAS float* scr = (LAS float*)(lds + wave * 16640); \
    (void)lane; (void)gw; (void)NGW; (void)gtid; (void)NGT; (void)HM; (void)Wgu; (void)Wd; (void)WinT; (void)WpaT; (void)WppT; (void)WoutT; (void)WgT; (void)XB; (void)X1; (void)Z2; (void)Dp; (void)Pm; (void)scr;

    if (IN(0)) { PH_BEGIN
        {   int base = 0;
            base = run_tr(args.in[1], Wgu, DM, FF, 1, 0, base, gw, NGW, scr, lane);
            base = run_tr(args.in[2], Wgu, DM, FF, 2, 0, base, gw, NGW, scr, lane);
            base = run_tr(args.in[3], Wd, FF, DM, 0, 0, base, gw, NGW, scr, lane);
            base = run_tr(args.in[6], WinT, DM, INW, 0, 0, base, gw, NGW, scr, lane);
            base = run_tr(args.in[10], WpaT, DM, DM, 0, 0, base, gw, NGW, scr, lane);
            base = run_tr(args.in[11], WppT, 1024, DM, 0, 0, base, gw, NGW, scr, lane);
            base = run_tr(args.in[12], WoutT, DM, DM, 0, 0, base, gw, NGW, scr, lane);
#pragma unroll 1
            for (int g = 0; g < 4; ++g) base = run_tr(args.in[8] + (size_t)g * 65536, WgT, 256, 256, 0, g * 256, base, gw, NGW, scr, lane);
        }
        const float* x = args.in[0];
        for (long i = gtid; i < (long)M * DM / 8; i += NGT) { const f32x4 a = ((const f32x4*)x)[2 * i], b = ((const f32x4*)x)[2 * i + 1];
            u32x4 o; o.x = pk2(a[0], a[1]); o.y = pk2(a[2], a[3]); o.z = pk2(b[0], b[1]); o.w = pk2(b[2], b[3]); ((u32x4*)XB)[i] = o; }
        __syncthreads();
    }
    SEAM(0);
    if (IN(1)) { PH_BEGIN
        pg8::Gemm g{XB, Wgu, DM, DM, DM, 0}; pg8::StaticOrder S; S.init(M, 2 * FF, G, bid);
        pg8::EpiSwiGLU E{HM, FF};
        pg8::gemm_phase<pg8::EpiSwiGLU, pg8::StaticOrder, true, true>(lds, g, S, E);
    }
    SEAM(1);
    if (IN(2)) { PH_BEGIN
        pg8::Gemm g{HM, Wd, FF, FF, FF, 0}; pg8::StaticOrder S; S.init(M, DM, G, bid);
        pg8::EpiResF32 E{args.in[0], out, DM, ALPHA, 0.5f};
        pg8::gemm_phase<pg8::EpiResF32, pg8::StaticOrder, true, true>(lds, g, S, E);
    }
    SEAM(2);
    if (IN(3)) { PH_BEGIN
        f32x4 gv[8], bv[8];
#pragma unroll
        for (int j = 0; j < 8; ++j) { gv[j] = ((const f32x4*)args.in[4] + lane)[64 * j]; bv[j] = ((const f32x4*)args.in[5] + lane)[64 * j]; }
        for (int m = gw; m < M; m += NGW) ln_row(out + (size_t)m * DM, gv, bv, X1 + (size_t)m * DM, XB + (size_t)m * DM, lane);
    }
    SEAM(3);
    if (IN(4)) { PH_BEGIN
        pg8::Gemm g{XB, WinT, DM, DM, DM, 0}; pg8::StaticOrder S; S.init(M, INW, G, bid);
        pg8::EpiBf16Sig E{HM, INW, COL_GA / 256};
        pg8::gemm_phase<pg8::EpiBf16Sig, pg8::StaticOrder, true, true>(lds, g, S, E);
    }
    SEAM(4);
    if (IN(5)) { PH_BEGIN
        for (int u = bid; u < (SEQ / 64) * NKVH; u += G) att::attn_unit((LAS char*)lds, HM, args.in[7], u & 3, u >> 2);
        for (long i = gtid; i < (long)M * 128; i += NGT) { const int t = (int)(i >> 7), c8 = (int)(i & 127), gsh = c8 >> 5, hw = 1 << gsh;
            const int s_lo = t - hw < 0 ? 0 : t - hw, s_hi = t + hw > SEQ ? SEQ : t + hw;
            float acc[8];
#pragma unroll
            for (int e = 0; e < 8; ++e) acc[e] = 0.f;
            const bf16_t* pp = HM + COL_P + c8 * 8;
            for (int s = s_lo; s < s_hi; ++s) { const u32x4 w = *(const u32x4*)(pp + (size_t)s * INW); f32x4 a, b; pg8::unpack8(w, a, b);
#pragma unroll
                for (int e = 0; e < 4; ++e) { acc[e] += a[e]; acc[4 + e] += b[e]; } }
            const float inv = 1.f / (float)(s_hi - s_lo);
            f32x4 a, b; pg8::unpack8(*(const u32x4*)(pp + (size_t)t * INW), a, b);
            u32x4 o; o.x = pk2(acc[0] * inv - a[0], acc[1] * inv - a[1]); o.y = pk2(acc[2] * inv - a[2], acc[3] * inv - a[3]);
            o.z = pk2(acc[4] * inv - b[0], acc[5] * inv - b[1]); o.w = pk2(acc[6] * inv - b[2], acc[7] * inv - b[3]);
            *(u32x4*)(Dp + (size_t)t * 1024 + c8 * 8) = o; }
        __syncthreads();
    }
    SEAM(5);
    if (IN(6)) { PH_BEGIN
        pg8::Gemm g{Dp, WgT, 256, 1024, 256, 256}; pg8::StaticOrder S; S.init(M, 1024, G, bid);
        pg8::EpiColScale E{Pm, 1024, args.in[9]};
        pg8::gemm_phase<pg8::EpiColScale, pg8::StaticOrder, true, true>(lds, g, S, E);
    }
    SEAM(6);
    if (IN(7)) { PH_BEGIN
        {   pg8::Gemm g{HM, WpaT, DM, INW, DM, 0}; pg8::StaticOrder S; S.init(M, DM, G, bid);
            pg8::EpiGate<false> E{XB, DM, HM + COL_GA, INW};
            pg8::gemm_phase<pg8::EpiGate<false>, pg8::StaticOrder, true, true>(lds, g, S, E); }
        {   pg8::Gemm g{Pm, WppT, 1024, 1024, 1024, 0}; pg8::StaticOrder S; S.init(M, DM, G, bid);
            pg8::EpiGate<true> E{XB, DM, HM + COL_GB, INW};
            pg8::gemm_phase<pg8::EpiGate<true>, pg8::StaticOrder, true, true>(lds, g, S, E); }
    }
    SEAM(7);
    if (IN(8)) { PH_BEGIN
        pg8::Gemm g{XB, WoutT, DM, DM, DM, 0}; pg8::StaticOrder S; S.init(M, DM, G, bid);
        pg8::EpiResF32 E{X1, Z2, DM, ALPHA, 1.0f};
        pg8::gemm_phase<pg8::EpiResF32, pg8::StaticOrder, true, true>(lds, g, S, E);
    }
    SEAM(8);
    if (IN(9)) { PH_BEGIN
        {   f32x4 gv[8], bv[8];
#pragma unroll
            for (int j = 0; j < 8; ++j) { gv[j] = ((const f32x4*)args.in[13] + lane)[64 * j]; bv[j] = ((const f32x4*)args.in[14] + lane)[64 * j]; }
            for (int m = gw; m < M; m += NGW) ln_row(Z2 + (size_t)m * DM, gv, bv, X1 + (size_t)m * DM, XB + (size_t)m * DM, lane); }
        {   int base = 0;
            base = run_tr(args.in[15], Wgu, DM, FF, 1, 0, base, gw, NGW, scr, lane);
            base = run_tr(args.in[16], Wgu, DM, FF, 2, 0, base, gw, NGW, scr, lane);
            base = run_tr(args.in[17], Wd, FF, DM, 0, 0, base, gw, NGW, scr, lane); }
        __syncthreads();
    }
    SEAM(9);
    if (IN(10)) { PH_BEGIN
        pg8::Gemm g{XB, Wgu, DM, DM, DM, 0}; pg8::StaticOrder S; S.init(M, 2 * FF, G, bid);
        pg8::EpiSwiGLU E{HM, FF};
        pg8::gemm_phase<pg8::EpiSwiGLU, pg8::StaticOrder, true, true>(lds, g, S, E);
    }
    SEAM(10);
    if (IN(11)) { PH_BEGIN
        pg8::Gemm g{HM, Wd, FF, FF, FF, 0}; pg8::StaticOrder S; S.init(M, DM, G, bid);
        pg8::EpiResF32 E{X1, out, DM, ALPHA, 0.5f};
        pg8::gemm_phase<pg8::EpiResF32, pg8::StaticOrder, true, true>(lds, g, S, E);
    }
    SEAM(11);
    if (IN(12)) { PH_BEGIN
        f32x4 gv[8], bv[8];
#pragma unroll
        for (int j = 0; j < 8; ++j) { gv[j] = ((const f32x4*)args.in[18] + lane)[64 * j]; bv[j] = ((const f32x4*)args.in[19] + lane)[64 * j]; }
        for (int m = gw; m < M; m += NGW) ln_row(out + (size_t)m * DM, gv, bv, out + (size_t)m * DM, nullptr, lane);
    }
#undef IN
#undef SEAM
#undef PH_BEGIN
}

#ifndef MK_PER_PHASE
#define MK_PER_PHASE 0
#endif
extern "C" void kernel_launch(void* const* d_in, const int* in_sizes, int n_in, void* d_out, int out_size, void* d_ws, size_t ws_size, hipStream_t stream) {
    static int grid = 0;
    if (grid == 0) {
        if (n_in != 20 || in_sizes[0] != M * DM || out_size != M * DM || ws_size < WS_END) {
            fprintf(stderr, "kernel_launch: unexpected shapes: n_in %d in0 %d out %d ws %zu (need %zu)\n", n_in, n_in > 0 ? in_sizes[0] : -1, out_size, ws_size, (size_t)WS_END); grid = -1; return; }
        int dev = 0, cus = 0, per_cu = 0;
        hipGetDevice(&dev); hipDeviceGetAttribute(&cus, hipDeviceAttributeMultiprocessorCount, dev);
        if (hipFuncSetAttribute((const void*)fwd_mega, hipFuncAttributeMaxDynamicSharedMemorySize, LDS_BYTES) != hipSuccess) { fprintf(stderr, "kernel_launch: hipFuncSetAttribute failed\n"); grid = -1; return; }
        if (hipOccupancyMaxActiveBlocksPerMultiprocessor(&per_cu, (const void*)fwd_mega, NTHREADS, LDS_BYTES) != hipSuccess || per_cu < 1) { fprintf(stderr, "kernel_launch: occupancy query says %d\n", per_cu); per_cu = 1; }
        (void)hipGetLastError();
        grid = cus * 1;
    }
    if (grid < 0) return;
    Args a{};
    for (int i = 0; i < 20; ++i) a.in[i] = (const float*)d_in[i];
    a.out = (float*)d_out; a.ws = (unsigned char*)d_ws;
#if MK_PER_PHASE
    for (int p = 0; p < N_PHASES; ++p) { a.ph_lo = p; a.ph_hi = p + 1; hipLaunchKernelGGL(fwd_mega, dim3(grid), dim3(NTHREADS), LDS_BYTES, stream, a); }
#else
    a.ph_lo = 0; a.ph_hi = N_PHASES;
    void* kargs[] = {&a};
    hipError_t e = hipLaunchCooperativeKernel((const void*)fwd_mega, dim3(grid), dim3(NTHREADS), kargs, LDS_BYTES, stream);
    if (e != hipSuccess) fprintf(stderr, "kernel_launch: cooperative launch failed: %s (grid %d)\n", hipGetErrorString(e), grid);
#endif
}
```

```cpp
#include <hip/hip_runtime.h>
#include <hip/hip_cooperative_groups.h>
#include <cstdio>
#include <cstdint>
namespace cg = cooperative_groups;

namespace pg8 {
#define PG8_LAS __attribute__((address_space(3)))
typedef unsigned short bf16_t;
typedef short bf16x8 __attribute__((ext_vector_type(8)));
typedef float f32x4 __attribute__((ext_vector_type(4)));
typedef unsigned u32x4 __attribute__((ext_vector_type(4)));
constexpr int BM = 256, BK = 64, HALF = 128, HTB = HALF * BK * 2  , STAGE_BYTES = 8 * HTB, NXCD = 8, WGM = 8;

__host__ __device__ __forceinline__ int lds_byte(int r, int c) { const int st = (r >> 4) * 2 + (c >> 5), rr = r & 15, cc = c & 31, ob = rr * 64 + cc * 2; return st * 1024 + (ob ^ (((ob >> 9) & 1) << 5)); }
__host__ __device__ __forceinline__ void stage_rc(int b, int& R, int& C) { const int st = b / 1024, sb = b % 1024, swz = sb ^ (((sb >> 9) & 1) << 5); R = (st >> 1) * 16 + swz / 64; C = (st & 1) * 32 + (swz % 64) / 2; }
__host__ __device__ __forceinline__ int perm32(int rho) { const int n = rho >> 4, i = rho & 15; return 8 * (i >> 2) + 4 * n + (i & 3); }

struct Unit { int pm, pn; };
struct Gemm { const bf16_t* A; const bf16_t* Bt; };

struct StaticOrder {
    int nM, nN, nwg, G, c;
    __host__ __device__ void init(int M, int N, int G_, int c_) { nM = M / BM; nN = N / BM; nwg = nM * nN; G = G_; c = c_; }
    __host__ __device__ bool next(int i, Unit& u) const {
        const long L = (long)i * G + c; if (L >= nwg) return false;
        int wgid = (int)L; { const int q = nwg / NXCD, r = nwg % NXCD, xcd = wgid % NXCD, off = wgid / NXCD; wgid = (xcd < r ? xcd * (q + 1) : r * (q + 1) + (xcd - r) * q) + off; }
        const int nig = WGM * nN, gid = wgid / nig, fm = gid * WGM, gsz = (nM - fm) < WGM ? (nM - fm) : WGM;
        u.pm = fm + ((wgid % nig) % gsz); u.pn = (wgid % nig) / gsz; return true;
    }
    __device__ __forceinline__ void a_ready(const Unit&) const {}
    __device__ __forceinline__ void done(const Unit&) const {}
};


__device__ __forceinline__ unsigned cvt_pk_bf16(float lo, float hi) { unsigned r; asm volatile("v_cvt_pk_bf16_f32 %0, %1, %2" : "=v"(r) : "v"(lo), "v"(hi)); return r; }
__device__ __forceinline__ float sigm(float v) { return __builtin_amdgcn_rcpf(1.f + __builtin_amdgcn_exp2f(-1.4426950408889634f * v)); }
__device__ __forceinline__ float bf_lo(unsigned w) { return __uint_as_float(w << 16); }
__device__ __forceinline__ float bf_hi(unsigned w) { return __uint_as_float(w & 0xffff0000u); }
__device__ __forceinline__ u32x4 pack8(const f32x4 v0, const f32x4 v1) { u32x4 w; w.x = cvt_pk_bf16(v0[0], v0[1]); w.y = cvt_pk_bf16(v0[2], v0[3]); w.z = cvt_pk_bf16(v1[0], v1[1]); w.w = cvt_pk_bf16(v1[2], v1[3]); return w; }
__device__ __forceinline__ void unpack8(const u32x4 w, f32x4& v0, f32x4& v1) { v0 = (f32x4){bf_lo(w.x), bf_hi(w.x), bf_lo(w.y), bf_hi(w.y)}; v1 = (f32x4){bf_lo(w.z), bf_hi(w.z), bf_lo(w.w), bf_hi(w.w)}; }

struct EpiSwiGLU {
    static constexpr bool PERM = true, AFTER_DRAIN = false;
    bf16_t* O; int ldc;
    __device__ __forceinline__ void operator()(const f32x4 (&acc)[2][2][4][2], const Unit& u, int wr, int wc, int fr, int fq) const {
        const int row0 = u.pm * BM + wr * 64 + fr, col0 = u.pn * HALF + wc * 32 + 8 * fq;
#pragma unroll
        for (int ai = 0; ai < 2; ++ai)
#pragma unroll
            for (int m = 0; m < 4; ++m) { bf16_t* rowp = O + (size_t)(row0 + ai * HALF + m * 16) * ldc + col0;
                f32x4 h0, h1;
#pragma unroll
                for (int j = 0; j < 4; ++j) { const float g0 = acc[ai][0][m][0][j], g1 = acc[ai][0][m][1][j];
                    h0[j] = g0 * sigm(g0) * acc[ai][1][m][0][j]; h1[j] = g1 * sigm(g1) * acc[ai][1][m][1][j]; }
                *(u32x4*)rowp = pack8(h0, h1); }
    }
};
struct EpiBf16Sig {
    static constexpr bool PERM = true, AFTER_DRAIN = false;
    bf16_t* O; int ldc; int sig_from;
    __device__ __forceinline__ void operator()(const f32x4 (&acc)[2][2][4][2], const Unit& u, int wr, int wc, int fr, int fq) const {
        const int row0 = u.pm * BM + wr * 64 + fr, col0 = u.pn * BM + wc * 32 + 8 * fq; const bool sg = u.pn >= sig_from;
#pragma unroll
        for (int ai = 0; ai < 2; ++ai)
#pragma unroll
            for (int m = 0; m < 4; ++m) { bf16_t* rowp = O + (size_t)(row0 + ai * HALF + m * 16) * ldc + col0;
#pragma unroll
                for (int bj = 0; bj < 2; ++bj) { f32x4 v0 = acc[ai][bj][m][0], v1 = acc[ai][bj][m][1];
                    if (sg) {
#pragma unroll
                        for (int j = 0; j < 4; ++j) { v0[j] = sigm(v0[j]); v1[j] = sigm(v1[j]); } }
                    *(u32x4*)(rowp + bj * HALF) = pack8(v0, v1); } }
    }
};
struct EpiColScale {
    static constexpr bool PERM = true, AFTER_DRAIN = false;
    bf16_t* O; int ldc; const float* scale;
    __device__ __forceinline__ void operator()(const f32x4 (&acc)[2][2][4][2], const Unit& u, int wr, int wc, int fr, int fq) const {
        const int row0 = u.pm * BM + wr * 64 + fr, col0 = u.pn * BM + wc * 32 + 8 * fq;
        f32x4 sv[2][2];
#pragma unroll
        for (int bj = 0; bj < 2; ++bj)
#pragma unroll
            for (int n = 0; n < 2; ++n) sv[bj][n] = *(const f32x4*)(scale + col0 + bj * HALF + 4 * n);
#pragma unroll
        for (int ai = 0; ai < 2; ++ai)
#pragma unroll
            for (int m = 0; m < 4; ++m) { bf16_t* rowp = O + (size_t)(row0 + ai * HALF + m * 16) * ldc + col0;
#pragma unroll
                for (int bj = 0; bj < 2; ++bj) *(u32x4*)(rowp + bj * HALF) = pack8(acc[ai][bj][m][0] * sv[bj][0], acc[ai][bj][m][1] * sv[bj][1]); }
    }
};
template <bool ADD> struct EpiGate {
    static constexpr bool PERM = true, AFTER_DRAIN = false;
    bf16_t* O; int ldc; const bf16_t* G; int ldg;
    __device__ __forceinline__ void operator()(const f32x4 (&acc)[2][2][4][2], const Unit& u, int wr, int wc, int fr, int fq) const {
        const int row0 = u.pm * BM + wr * 64 + fr, col0 = u.pn * BM + wc * 32 + 8 * fq;
#pragma unroll
        for (int ai = 0; ai < 2; ++ai) {
            u32x4 gq[4][2], tq[4][2];
#pragma unroll
            for (int m = 0; m < 4; ++m) { const size_t r = (size_t)(row0 + ai * HALF + m * 16);
#pragma unroll
                for (int bj = 0; bj < 2; ++bj) { gq[m][bj] = *(const u32x4*)(G + r * ldg + col0 + bj * HALF); if (ADD) tq[m][bj] = *(const u32x4*)(O + r * ldc + col0 + bj * HALF); } }
#pragma unroll
            for (int m = 0; m < 4; ++m) { const size_t r = (size_t)(row0 + ai * HALF + m * 16);
#pragma unroll
                for (int bj = 0; bj < 2; ++bj) { f32x4 g0, g1; unpack8(gq[m][bj], g0, g1);
                    f32x4 v0 = acc[ai][bj][m][0] * g0, v1 = acc[ai][bj][m][1] * g1;
                    if (ADD) { f32x4 t0, t1; unpack8(tq[m][bj], t0, t1); v0 += t0; v1 += t1; }
                    *(u32x4*)(O + r * ldc + col0 + bj * HALF) = pack8(v0, v1); } }
            asm volatile("" ::: "memory"); }
    }
};
struct EpiResF32 {
    static constexpr bool PERM = false, AFTER_DRAIN = false;
    const float* res; float* out; int ldc; float ra, sa;
    __device__ __forceinline__ void operator()(const f32x4 (&acc)[2][2][4][2], const Unit& u, int wr, int wc, int fr, int fq) const {
        const int col0 = u.pn * BM + wc * 32 + 4 * fq;
#pragma unroll
        for (int ai = 0; ai < 2; ++ai) {
            f32x4 rs[4][2][2];
#pragma unroll
            for (int m = 0; m < 4; ++m) { const size_t off = (size_t)(u.pm * BM + ai * HALF + wr * 64 + m * 16 + fr) * ldc + col0;
#pragma unroll
                for (int bj = 0; bj < 2; ++bj)
#pragma unroll
                    for (int n = 0; n < 2; ++n) rs[m][bj][n] = *(const f32x4*)(res + off + bj * HALF + n * 16); }
#pragma unroll
            for (int m = 0; m < 4; ++m) { const size_t off = (size_t)(u.pm * BM + ai * HALF + wr * 64 + m * 16 + fr) * ldc + col0;
#pragma unroll
                for (int bj = 0; bj < 2; ++bj)
#pragma unroll
                    for (int n = 0; n < 2; ++n) *(f32x4*)(out + off + bj * HALF + n * 16) = rs[m][bj][n] * ra + acc[ai][bj][m][n] * sa; }
            asm volatile("" ::: "memory"); }
    }
};

template <class Epi, class Sched, bool ALIGN_EPI, bool SP2, int K_, int LDA, int LDB, int ACOL>
__device__ __forceinline__ void gemm_phase(PG8_LAS unsigned char* lds, const Gemm g, const Sched& S, const Epi& E) {
    int tid = threadIdx.x; asm volatile("" : "+v"(tid)); const int wid = __builtin_amdgcn_readfirstlane(tid >> 6), lane = tid & 63, wr = wid >> 2, wc = wid & 3, fr = lane & 15, fq = lane >> 4;
    constexpr int K = K_, nt = K / BK; static_assert(K % 128 == 0 && K >= 256, "K");
    unsigned voffA[2], voffB[2];
#pragma unroll
    for (int i = 0; i < 2; ++i) { int R, C; stage_rc(tid * 16 + i * 8192, R, C); const int Rb = Epi::PERM ? ((R & ~31) + perm32(R & 31)) : R;
        voffA[i] = (unsigned)(R * LDA + C) * 2u; voffB[i] = (unsigned)(Rb * LDB + C) * 2u; }
    const size_t kstep = (size_t)(BK * 2);
    constexpr size_t hstepA = (size_t)HALF * LDA * 2, hstepB = (size_t)HALF * LDB * 2;
    constexpr size_t tstepA = 2 * hstepA, tstepB = 2 * hstepB, pnA = (size_t)ACOL * 2;
    const unsigned ldsw = (unsigned)wid * 1024u;
    const int aoff = lds_byte(wr * 64 + fr, fq * 8), boff = lds_byte(wc * 32 + fr, fq * 8);
#define PG8_SA(b, h) (((b) * 2 + (h)) * HTB)
#define PG8_SB(b, h) ((4 + (b) * 2 + (h)) * HTB)
#define PG8_STAGE(bufoff, gbase, voff) do { _Pragma("unroll") for (int _i = 0; _i < 2; ++_i) \
        __builtin_amdgcn_global_load_lds((const unsigned*)((const char*)(gbase) + (voff)[_i]), (PG8_LAS unsigned*)(lds + (bufoff) + ldsw + _i * 8192), 16, 0, 0); } while (0)
#define PG8_LDA(dst, b, h) do { _Pragma("unroll") for (int m = 0; m < 4; ++m) _Pragma("unroll") for (int k = 0; k < 2; ++k) dst[m][k] = *(const PG8_LAS bf16x8*)(lds + PG8_SA(b, h) + aoff + m * 2048 + k * 1024); } while (0)
#define PG8_LDB(dst, b, h) do { _Pragma("unroll") for (int n = 0; n < 2; ++n) _Pragma("unroll") for (int k = 0; k < 2; ++k) dst[n][k] = *(const PG8_LAS bf16x8*)(lds + PG8_SB(b, h) + boff + n * 2048 + k * 1024); } while (0)
#define PG8_MMA(ai, bj, At, Bt) do { __builtin_amdgcn_s_setprio(1); _Pragma("unroll") for (int m = 0; m < 4; ++m) _Pragma("unroll") for (int n = 0; n < 2; ++n) _Pragma("unroll") for (int k = 0; k < 2; ++k) \
        acc[ai][bj][m][n] = __builtin_amdgcn_mfma_f32_16x16x32_bf16(Bt[n][k], At[m][k], acc[ai][bj][m][n], 0, 0, 0); __builtin_amdgcn_s_setprio(0); } while (0)
#define PG8_WAIT_V(n) asm volatile("s_waitcnt vmcnt(" #n ")" ::: "memory")
#define PG8_WAIT_L(n) asm volatile("s_waitcnt lgkmcnt(" #n ")" ::: "memory")
#define PG8_BAR __builtin_amdgcn_s_barrier()
#define PG8_SCHED __builtin_amdgcn_sched_barrier(0)
    Unit cur, nxt; int ui = 0;
    if (!S.next(0, cur)) return;
    f32x4 acc[2][2][4][2];
#pragma unroll
    for (int a = 0; a < 2; ++a)
#pragma unroll
        for (int b = 0; b < 2; ++b)
#pragma unroll
            for (int m = 0; m < 4; ++m)
#pragma unroll
                for (int n = 0; n < 2; ++n) acc[a][b][m][n] = (f32x4){0.f, 0.f, 0.f, 0.f};
    bf16x8 At[4][2], B0[2][2], B1[2][2];
    const char* cA = (const char*)g.A + (size_t)cur.pm * tstepA + (size_t)cur.pn * pnA; const char* cB = (const char*)g.Bt + (size_t)cur.pn * tstepB;
    S.a_ready(cur);
    if constexpr (SP2) {
        PG8_STAGE(PG8_SB(0, 0), cB, voffB); PG8_STAGE(PG8_SB(0, 1), cB + hstepB, voffB); PG8_STAGE(PG8_SA(0, 0), cA, voffA); PG8_STAGE(PG8_SA(0, 1), cA + hstepA, voffA);
        if (wr == 1) PG8_BAR;
        PG8_WAIT_V(2); PG8_BAR;
        PG8_STAGE(PG8_SB(1, 0), cB + kstep, voffB); PG8_STAGE(PG8_SA(1, 0), cA + kstep, voffA); PG8_STAGE(PG8_SB(1, 1), cB + hstepB + kstep, voffB);
        PG8_WAIT_V(6); PG8_BAR;
    } else {
        PG8_STAGE(PG8_SB(0, 0), cB, voffB); PG8_STAGE(PG8_SA(0, 0), cA, voffA); PG8_STAGE(PG8_SB(0, 1), cB + hstepB, voffB); PG8_STAGE(PG8_SA(0, 1), cA + hstepA, voffA);
        if (wr == 1) PG8_BAR;
        PG8_WAIT_V(4); PG8_BAR;
        PG8_STAGE(PG8_SB(1, 0), cB + kstep, voffB); PG8_STAGE(PG8_SA(1, 0), cA + kstep, voffA); PG8_STAGE(PG8_SB(1, 1), cB + hstepB + kstep, voffB);
        PG8_WAIT_V(6); PG8_BAR;
    }
    for (;;) {
        const bool has_next = S.next(ui + 1, nxt);
        const char* nA = has_next ? (const char*)g.A + (size_t)nxt.pm * tstepA + (size_t)nxt.pn * pnA : cA; const char* nB = has_next ? (const char*)g.Bt + (size_t)nxt.pn * tstepB : cB;
        for (int t = 0; t < nt; t += 2) {
            const bool last = (t == nt - 2);
            const char* a1 = cA + (size_t)(t + 1) * kstep;
            const char* a2 = last ? nA : cA + (size_t)(t + 2) * kstep; const char* b2 = last ? nB : cB + (size_t)(t + 2) * kstep;
            const char* a3 = a2 + kstep; const char* b3 = b2 + kstep;
            if (last && has_next) S.a_ready(nxt);
            if constexpr (SP2) {
            PG8_LDB(B0, 0, 0); PG8_LDB(B1, 0, 1); PG8_SCHED; PG8_LDA(At, 0, 0); PG8_STAGE(PG8_SA(1, 1), a1 + hstepA, voffA);
            PG8_WAIT_V(8); PG8_WAIT_L(0); PG8_BAR; PG8_MMA(0, 0, At, B0); PG8_MMA(0, 1, At, B1); PG8_BAR; PG8_SCHED;
            PG8_LDA(At, 0, 1); PG8_STAGE(PG8_SB(0, 0), b2, voffB); PG8_STAGE(PG8_SB(0, 1), b2 + hstepB, voffB); PG8_STAGE(PG8_SA(0, 0), a2, voffA);
            PG8_WAIT_V(8); PG8_WAIT_L(0); PG8_BAR; PG8_MMA(1, 0, At, B0); PG8_MMA(1, 1, At, B1); PG8_BAR; PG8_SCHED;
            PG8_LDB(B0, 1, 0); PG8_LDB(B1, 1, 1); PG8_SCHED; PG8_LDA(At, 1, 0); PG8_STAGE(PG8_SA(0, 1), a2 + hstepA, voffA);
            PG8_WAIT_V(8); PG8_WAIT_L(0); PG8_BAR; PG8_MMA(0, 0, At, B0); PG8_MMA(0, 1, At, B1); PG8_BAR; PG8_SCHED;
            PG8_LDA(At, 1, 1); PG8_STAGE(PG8_SB(1, 0), b3, voffB); PG8_STAGE(PG8_SB(1, 1), b3 + hstepB, voffB); PG8_STAGE(PG8_SA(1, 0), a3, voffA);
            PG8_WAIT_V(8); PG8_WAIT_L(0); PG8_BAR; PG8_MMA(1, 0, At, B0); PG8_MMA(1, 1, At, B1); PG8_BAR; PG8_SCHED;
            } else {
            PG8_LDB(B0, 0, 0); PG8_SCHED; PG8_LDA(At, 0, 0); PG8_STAGE(PG8_SA(1, 1), a1 + hstepA, voffA);
            PG8_WAIT_L(8); PG8_BAR; PG8_WAIT_L(0); PG8_MMA(0, 0, At, B0); PG8_BAR; PG8_SCHED;
            PG8_LDB(B1, 0, 1); PG8_STAGE(PG8_SB(0, 0), b2, voffB);
            PG8_BAR; PG8_WAIT_L(0); PG8_MMA(0, 1, At, B1); PG8_BAR;
            PG8_LDA(At, 0, 1); PG8_STAGE(PG8_SA(0, 0), a2, voffA);
            PG8_BAR; PG8_WAIT_L(0); PG8_MMA(1, 0, At, B0); PG8_BAR; PG8_SCHED;
            PG8_STAGE(PG8_SB(0, 1), b2 + hstepB, voffB);
            PG8_WAIT_V(6); PG8_BAR; PG8_MMA(1, 1, At, B1); PG8_BAR;
            PG8_LDB(B0, 1, 0); PG8_SCHED; PG8_LDA(At, 1, 0); PG8_STAGE(PG8_SA(0, 1), a2 + hstepA, voffA);
            PG8_WAIT_L(8); PG8_BAR; PG8_WAIT_L(0); PG8_MMA(0, 0, At, B0); PG8_BAR; PG8_SCHED;
            PG8_LDB(B1, 1, 1); PG8_STAGE(PG8_SB(1, 0), b3, voffB);
            PG8_BAR; PG8_WAIT_L(0); PG8_MMA(0, 1, At, B1); PG8_BAR;
            PG8_LDA(At, 1, 1); PG8_STAGE(PG8_SA(1, 0), a3, voffA);
            PG8_BAR; PG8_WAIT_L(0); PG8_MMA(1, 0, At, B0); PG8_BAR; PG8_SCHED;
            PG8_STAGE(PG8_SB(1, 1), b3 + hstepB, voffB);
            PG8_WAIT_V(6); PG8_BAR; PG8_MMA(1, 1, At, B1); PG8_BAR;
            }
        }
        if constexpr (ALIGN_EPI) { if (wr == 0) PG8_BAR; }
        if constexpr (!Epi::AFTER_DRAIN) { E(acc, cur, wr, wc, fr, fq); S.done(cur); }
        if (!has_next) break;
#pragma unroll
        for (int a = 0; a < 2; ++a)
#pragma unroll
            for (int b = 0; b < 2; ++b)
#pragma unroll
                for (int m = 0; m < 4; ++m)
#pragma unroll
                    for (int n = 0; n < 2; ++n) acc[a][b][m][n] = (f32x4){0.f, 0.f, 0.f, 0.f};
        cur = nxt; cA = nA; cB = nB; ++ui;
        if constexpr (ALIGN_EPI) { if (wr == 1) PG8_BAR; }
    }
    PG8_WAIT_V(0);
    if constexpr (!ALIGN_EPI) { if (wr == 0) PG8_BAR; }
    PG8_BAR;
    if constexpr (Epi::AFTER_DRAIN) { E.fused(acc, cur, wr, wc, fr, fq, lds, wid, lane); S.done(cur); }
#undef PG8_SA
#undef PG8_SB
#undef PG8_STAGE
#undef PG8_LDA
#undef PG8_LDB
#undef PG8_MMA
#undef PG8_WAIT_V
#undef PG8_WAIT_L
#undef PG8_BAR
#undef PG8_SCHED
}
}

#define LAS __attribute__((address_space(3)))
typedef unsigned short bf16_t;
typedef float f32x4 __attribute__((ext_vector_type(4)));
typedef unsigned u32x4 __attribute__((ext_vector_type(4)));
constexpr int M = 16384, DM = 2048, FF = 5632, INW = 8192, SEQ = 16384;
constexpr int NQH = 16, NKVH = 4, HD = 128;
constexpr int COL_K = 2048, COL_V = 2560, COL_P = 3072, COL_GA = 4096, COL_GB = 6144;
constexpr float ALPHA = 1.189207115002721f;
constexpr float LN_EPS = 1e-5f;

namespace att {
using bf16x8 = __attribute__((ext_vector_type(8))) short;
using s16x4  = __attribute__((ext_vector_type(4))) short;
using f32x16 = __attribute__((ext_vector_type(16))) float;
#define KSWZ(row, colB) ((row) * 256 + ((colB) ^ (((row) & 7) << 4)))
#define SBAR() __builtin_amdgcn_sched_barrier(0)
__device__ __forceinline__ int crow(int r, int hi) { return (r & 3) + 8 * (r >> 2) + 4 * hi; }
__device__ __forceinline__ unsigned cvtpk(float lo, float hi) { unsigned r; asm volatile("v_cvt_pk_bf16_f32 %0, %1, %2" : "=v"(r) : "v"(lo), "v"(hi)); return r; }
__device__ __forceinline__ int v_st(int k, int c) { const int kk = (k & ~0xC) | ((k & 4) << 1) | ((k & 8) >> 1); return ((kk >> 3) * 4 + (c >> 5)) * 512 + ((kk & 7) * 32 + (c & 31)) * 2; }
__device__ __forceinline__ int v_rd_base(int lane) { return ((lane & 3) << 3) | (((lane >> 2) & 3) << 6) | (((lane >> 4) & 1) << 5) | (((lane >> 5) & 1) << 8); }
constexpr int v_rd_off(int d0, int ks, int half) { return d0 * 512 + ks * 4096 + half * 2048; }
template <int OFF> __device__ __forceinline__ s16x4 tr_read(int vb) {
  s16x4 r; asm volatile("ds_read_b64_tr_b16 %0, %1 offset:%2" : "=&v"(r) : "v"(vb), "i"(OFF) : "memory"); return r;
}
template <int D0> __device__ __forceinline__ void pv_one(f32x16& od, int vb, bf16x8 pa0, bf16x8 pa1, bf16x8 pa2, bf16x8 pa3) {
  const s16x4 l0 = tr_read<v_rd_off(D0, 0, 0)>(vb), h0 = tr_read<v_rd_off(D0, 0, 1)>(vb), l1 = tr_read<v_rd_off(D0, 1, 0)>(vb), h1 = tr_read<v_rd_off(D0, 1, 1)>(vb);
  const s16x4 l2 = tr_read<v_rd_off(D0, 2, 0)>(vb), h2 = tr_read<v_rd_off(D0, 2, 1)>(vb), l3 = tr_read<v_rd_off(D0, 3, 0)>(vb), h3 = tr_read<v_rd_off(D0, 3, 1)>(vb);
  asm volatile("s_waitcnt lgkmcnt(0)" ::: "memory"); SBAR();
#define PK(L, H) (bf16x8){L[0], L[1], L[2], L[3], H[0], H[1], H[2], H[3]}
  od = __builtin_amdgcn_mfma_f32_32x32x16_bf16(pa0, PK(l0, h0), od, 0, 0, 0);
  od = __builtin_amdgcn_mfma_f32_32x32x16_bf16(pa1, PK(l1, h1), od, 0, 0, 0);
  od = __builtin_amdgcn_mfma_f32_32x32x16_bf16(pa2, PK(l2, h2), od, 0, 0, 0);
  od = __builtin_amdgcn_mfma_f32_32x32x16_bf16(pa3, PK(l3, h3), od, 0, 0, 0);
#undef PK
}
__device__ __forceinline__ void qkt(f32x16& p0, f32x16& p1, const LAS char* Ks, const bf16x8* qr, int r32, int hi) {
  p0 = f32x16{}; p1 = f32x16{};
#pragma unroll
  for (int d0 = 0; d0 < 8; ++d0) { const int cb = (d0 * 16 + hi * 8) * 2;
    const bf16x8 b0 = *(const LAS bf16x8*)(Ks + KSWZ(r32, cb));
    const bf16x8 b1 = *(const LAS bf16x8*)(Ks + KSWZ(32 + r32, cb));
    p0 = __builtin_amdgcn_mfma_f32_32x32x16_bf16(b0, qr[d0], p0, 0, 0, 0);
    p1 = __builtin_amdgcn_mfma_f32_32x32x16_bf16(b1, qr[d0], p1, 0, 0, 0); }
}
constexpr int ATT_BUF = 32768, ATT_SCR = 65536, ATT_OST = 67584, ATT_LDS = ATT_OST + 8 * 8192;

__device__ __forceinline__ void attn_unit(LAS char* lds, bf16_t* HMq, const float* __restrict__ sink, int kvh, int qb) {
  int tid = threadIdx.x; asm volatile("" : "+v"(tid)); const int wid = tid >> 6, lane = tid & 63, r32 = lane & 31, hi = lane >> 5;
  LAS float* wsf = (LAS float*)(lds + ATT_SCR) + wid * 64; LAS float* al_l = wsf; LAS float* li_l = wsf + 32;
  LAS char* ost = lds + ATT_OST + wid * 8192;
  const int hq = kvh * 4 + (wid >> 1), t0 = qb * 64, trow0 = t0 + 32 * (wid & 1), tq = trow0 + r32;
  constexpr float LOG2E = 1.4426950408889634f, C = 0.088388347648318440f * LOG2E, NEG = -1e30f;
  const int jlo = t0 < 128 ? (128 - t0) >> 6 : 0, jhi = (SEQ + 128 - t0) >> 6 < 5 ? (SEQ + 128 - t0) >> 6 : 5;
  const int sr = tid >> 4, sc = (tid & 15) * 8, vst0 = v_st(sr, sc), vst1 = v_st(32 + sr, sc), kst0 = KSWZ(sr, sc * 2), kst1 = KSWZ(32 + sr, sc * 2);
  const bf16_t* kvp = HMq + COL_K + kvh * HD + sc;
  bf16x8 k0v, k1v, v0v, v1v;
#define ATT_LOAD(j) do { const bf16_t* kr0 = kvp + (size_t)(t0 - 128 + 64 * (j) + sr) * INW; const bf16_t* kr1 = kr0 + (size_t)32 * INW; \
    k0v = *(const bf16x8*)kr0; k1v = *(const bf16x8*)kr1; v0v = *(const bf16x8*)(kr0 + (COL_V - COL_K)); v1v = *(const bf16x8*)(kr1 + (COL_V - COL_K)); } while (0)
  ATT_LOAD(jlo);
  bf16x8 qr[8];
  { const bf16_t* Qw = HMq + (size_t)tq * INW + hq * HD + hi * 8;
#pragma unroll
    for (int d0 = 0; d0 < 8; ++d0) qr[d0] = *(const bf16x8*)(Qw + d0 * 16); }
  const float slope2 = __builtin_amdgcn_exp2f(-0.5f * (float)(hq + 1)) * LOG2E;
  float m_reg = sink[hq] * LOG2E, l_reg = 1.f;
  f32x16 o[4];
#pragma unroll
  for (int d = 0; d < 4; ++d) o[d] = f32x16{};
  int cur = 0;
  for (int j = jlo; j < jhi; ++j) {
    LAS char* V_lds = lds + cur * ATT_BUF; LAS char* K_lds = V_lds + 16384;
    *(LAS bf16x8*)(V_lds + vst0) = v0v; *(LAS bf16x8*)(V_lds + vst1) = v1v; *(LAS bf16x8*)(K_lds + kst0) = k0v; *(LAS bf16x8*)(K_lds + kst1) = k1v;
    __syncthreads();
    if (j + 1 < jhi) ATT_LOAD(j + 1);
    const int vb0 = (int)(uintptr_t)V_lds + v_rd_base(lane);
    f32x16 p0, p1;
    qkt(p0, p1, K_lds, qr, r32, hi);
    const float fd = (float)(tq - (t0 - 128 + 64 * j) - 4 * hi);
    float pmax = NEG;
#pragma unroll
    for (int r = 0; r < 16; ++r) { const float cr = (float)((r & 3) + 8 * (r >> 2));
      const float d0 = fabsf(fd - cr), d1 = fabsf(fd - cr - 32.f);
      const float s0 = fmaf(p0[r], C, -slope2 * d0), s1 = fmaf(p1[r], C, -slope2 * d1);
      p0[r] = d0 <= 128.f ? s0 : NEG; p1[r] = d1 <= 128.f ? s1 : NEG;
      pmax = fmaxf(pmax, fmaxf(p0[r], p1[r])); }
    { auto rr = __builtin_amdgcn_permlane32_swap(__float_as_uint(pmax), __float_as_uint(pmax), false, false);
      pmax = fmaxf(__uint_as_float(rr[0]), __uint_as_float(rr[1])); }
    const float mn = fmaxf(m_reg, pmax), alpha = __builtin_amdgcn_exp2f(m_reg - mn); m_reg = mn;
    float ps = 0.f;
#pragma unroll
    for (int r = 0; r < 16; ++r) { p0[r] = __builtin_amdgcn_exp2f(p0[r] - mn); p1[r] = __builtin_amdgcn_exp2f(p1[r] - mn); ps += p0[r] + p1[r]; }
    { auto rr = __builtin_amdgcn_permlane32_swap(__float_as_uint(ps), __float_as_uint(ps), false, false);
      ps = __uint_as_float(rr[0]) + __uint_as_float(rr[1]); }
    l_reg = l_reg * alpha + ps;
    if (hi == 0) al_l[r32] = alpha;
    asm volatile("s_waitcnt lgkmcnt(0)" ::: "memory");
#pragma unroll
    for (int r = 0; r < 16; ++r) { const float a = al_l[crow(r, hi)];
#pragma unroll
      for (int d = 0; d < 4; ++d) o[d][r] *= a; }
    bf16x8 pa0, pa1, pa2, pa3;
#define PK4(P, BASE, OUT) do { unsigned a0 = cvtpk(P[BASE + 0], P[BASE + 1]), a1 = cvtpk(P[BASE + 2], P[BASE + 3]);   \
    unsigned b0 = cvtpk(P[BASE + 4], P[BASE + 5]), b1 = cvtpk(P[BASE + 6], P[BASE + 7]);                              \
    auto r0 = __builtin_amdgcn_permlane32_swap(a0, b0, false, false); auto r1 = __builtin_amdgcn_permlane32_swap(a1, b1, false, false); \
    u32x4 w = {r0[0], r1[0], r0[1], r1[1]}; OUT = *reinterpret_cast<bf16x8*>(&w); } while (0)
    PK4(p0, 0, pa0); PK4(p0, 8, pa1); PK4(p1, 0, pa2); PK4(p1, 8, pa3);
#undef PK4
    pv_one<0>(o[0], vb0, pa0, pa1, pa2, pa3); pv_one<1>(o[1], vb0, pa0, pa1, pa2, pa3); pv_one<2>(o[2], vb0, pa0, pa1, pa2, pa3); pv_one<3>(o[3], vb0, pa0, pa1, pa2, pa3);
    cur ^= 1;
  }
#undef ATT_LOAD
  if (hi == 0) li_l[r32] = l_reg;
  asm volatile("s_waitcnt lgkmcnt(0)" ::: "memory");
#pragma unroll
  for (int r = 0; r < 16; ++r) { const int orow = crow(r, hi); const float rl = __builtin_amdgcn_rcpf(li_l[orow]);
#pragma unroll
    for (int d0 = 0; d0 < 4; ++d0) *(LAS unsigned short*)(ost + orow * 256 + (d0 * 32 + r32) * 2) = (unsigned short)(cvtpk(o[d0][r] * rl, 0.f) & 0xffffu); }
  asm volatile("s_waitcnt lgkmcnt(0)" ::: "memory");
  bf16_t* Ow = HMq + (size_t)trow0 * INW + hq * HD;
#pragma unroll
  for (int i = 0; i < 8; ++i) { const int id = i * 64 + lane, row = id >> 4, ch = id & 15;
    *(u32x4*)(Ow + (size_t)row * INW + ch * 8) = *(const LAS u32x4*)(ost + row * 256 + ch * 16); }
  __syncthreads();
}
}


template <int HW> __device__ __forceinline__ void pool_item(const bf16_t* __restrict__ HMp, bf16_t* __restrict__ Dp, int tb, int c8) {
    constexpr int NR = 16 + 2 * HW;
    const int t0 = tb * 16; const bf16_t* pp = HMp + COL_P + c8 * 8;
    u32x4 R[NR];
#pragma unroll
    for (int k = 0; k < NR; ++k) { const int t = t0 - HW + k; R[k] = (t >= 0 && t < SEQ) ? *(const u32x4*)(pp + (size_t)t * INW) : (u32x4){0u, 0u, 0u, 0u}; }
    f32x4 Sa = {0.f, 0.f, 0.f, 0.f}, Sb = {0.f, 0.f, 0.f, 0.f};
#pragma unroll
    for (int k = 0; k < 2 * HW; ++k) { f32x4 a, b; pg8::unpack8(R[k], a, b); Sa += a; Sb += b; }
#pragma unroll
    for (int i = 0; i < 16; ++i) { const int t = t0 + i; const int lo = t - HW < 0 ? 0 : t - HW, hi = t + HW > SEQ ? SEQ : t + HW;
        const float inv = 1.f / (float)(hi - lo);
        f32x4 a, b; pg8::unpack8(R[i + HW], a, b);
        *(u32x4*)(Dp + (size_t)t * 1024 + c8 * 8) = pg8::pack8(Sa * inv - a, Sb * inv - b);
        if (i < 15) { f32x4 na, nb, oa, ob; pg8::unpack8(R[i + 2 * HW], na, nb); pg8::unpack8(R[i], oa, ob); Sa += na - oa; Sb += nb - ob; } }
}

constexpr size_t MiB = 1u << 20;
constexpr size_t WS_HM = 0;
constexpr size_t WS_WFF = 176 * MiB;
constexpr size_t WS_WM = 256 * MiB;
constexpr size_t WS_XB = 310 * MiB;
constexpr size_t WS_X1 = 374 * MiB;
constexpr size_t WS_END = 502 * MiB;
constexpr size_t OFF_WD = (size_t)2 * FF * DM * 2;
constexpr size_t OFF_WPA = (size_t)INW * DM * 2, OFF_WPP = OFF_WPA + (size_t)DM * DM * 2, OFF_WOUT = OFF_WPP + (size_t)DM * 1024 * 2, OFF_WG = OFF_WOUT + (size_t)DM * DM * 2;
static_assert(WS_WFF + OFF_WD + (size_t)DM * FF * 2 <= WS_WM && (size_t)M * FF * 2 <= WS_WFF && WS_WM + OFF_WG + 1024 * 256 * 2 <= WS_XB, "ws map");

constexpr int NWAVES = 8, NTHREADS = 512;
constexpr int LDS_BYTES = 147456;

__device__ __forceinline__ unsigned f2bf(float f) { unsigned u = __builtin_bit_cast(unsigned, f); return (u + 0x7fffu + ((u >> 16) & 1u)) >> 16; }
__device__ __forceinline__ unsigned pk2(float lo, float hi) { return f2bf(lo) | (f2bf(hi) << 16); }
__device__ __forceinline__ float wave_sum(float v) {
#pragma unroll
    for (int o = 1; o < 64; o <<= 1) v += __shfl_xor(v, o);
    return v;
}
__device__ __forceinline__ void tr_item(const float* __restrict__ W, int K, int N, bf16_t* WT, int mode, int row_off, LAS float* scr, int item, int lane) {
    const int nblk = N >> 6, kb = item / nblk, nb = item - kb * nblk, k0 = kb << 6, n0 = nb << 6;
    const int orow0 = mode == 0 ? row_off + n0 : ((n0 >> 7) << 8) + (n0 & 127) + (mode == 2 ? 128 : 0);
    const int lc = (lane & 15) * 4, lr = lane >> 4;
#pragma unroll 4
    for (int i = 0; i < 16; ++i) { const int k = 4 * i + lr; const f32x4 v = *(const f32x4*)(W + (size_t)(k0 + k) * N + n0 + lc);
        LAS float* s = scr + k * 65 + lc; s[0] = v[0]; s[1] = v[1]; s[2] = v[2]; s[3] = v[3]; }
    asm volatile("s_waitcnt lgkmcnt(0)" ::: "memory");
    const int kc = lane & 7;
#pragma unroll
    for (int j = 0; j < 8; ++j) { const int n = 8 * j + (lane >> 3); const LAS float* s = scr + (8 * kc) * 65 + n;
        u32x4 o; o.x = pk2(s[0 * 65], s[1 * 65]); o.y = pk2(s[2 * 65], s[3 * 65]); o.z = pk2(s[4 * 65], s[5 * 65]); o.w = pk2(s[6 * 65], s[7 * 65]);
        *(u32x4*)(WT + (size_t)(orow0 + n) * K + k0 + 8 * kc) = o; }
    asm volatile("s_waitcnt lgkmcnt(0)" ::: "memory");
}
__device__ __forceinline__ int run_tr(const float* W, bf16_t* WT, int K, int N, int mode, int row_off, int base, int gw, int NGW, LAS float* scr, int lane) {
    const int ni = (K >> 6) * (N >> 6);
    int st = gw - base; if (st < 0) st += NGW;
    for (int it = st; it < ni; it += NGW) tr_item(W, K, N, WT, mode, row_off, scr, it, lane);
    return (base + ni) % NGW;
}

__device__ __forceinline__ void ln_row(const float* zrow, const f32x4 (&gv)[8], const f32x4 (&bv)[8], float* xo, bf16_t* xb, int lane) {
    const f32x4* zr = (const f32x4*)zrow + lane;
    f32x4 v[8]; float s = 0.f;
#pragma unroll
    for (int j = 0; j < 8; ++j) { v[j] = zr[64 * j]; s += (v[j][0] + v[j][1]) + (v[j][2] + v[j][3]); }
    const float mean = wave_sum(s) * (1.f / DM); float s2 = 0.f;
#pragma unroll
    for (int j = 0; j < 8; ++j) { v[j] = v[j] - mean; s2 += (v[j][0] * v[j][0] + v[j][1] * v[j][1]) + (v[j][2] * v[j][2] + v[j][3] * v[j][3]); }
    const float rstd = 1.f / sqrtf(wave_sum(s2) * (1.f / DM) + LN_EPS);
#pragma unroll
    for (int j = 0; j < 8; ++j) { const f32x4 y = v[j] * rstd * gv[j] + bv[j];
        if (xo) ((f32x4*)xo + lane)[64 * j] = y;
        if (xb) ((unsigned long long*)xb + lane)[64 * j] = (unsigned long long)pk2(y[0], y[1]) | ((unsigned long long)pk2(y[2], y[3]) << 32); }
}

struct Args { const float* in[20]; float* out; unsigned char* ws; int ph_lo, ph_hi; };
static_assert(sizeof(Args) == 184, "kernarg layout");
constexpr int N_PHASES = 13;

__global__ void __launch_bounds__(NTHREADS, 2) fwd_mega(Args args) {
    extern __shared__ __attribute__((aligned(16))) unsigned char lds_raw[];
    LAS unsigned char* lds = (LAS unsigned char*)lds_raw;
    cg::grid_group grid = cg::this_grid();
    __builtin_assume(__builtin_amdgcn_workitem_id_y() == 0); __builtin_assume(__builtin_amdgcn_workitem_id_z() == 0);
#define CAS __attribute__((address_space(4)))
#define KA_PTR(T, off) (*(T const CAS*)(ka + (off)))
#define ARG_IN(i) KA_PTR(const float*, 8 * (i))
    int lo, hi; { const unsigned char CAS* ka = (const unsigned char CAS*)__builtin_amdgcn_kernarg_segment_ptr(); lo = KA_PTR(int, 176); hi = KA_PTR(int, 180); }
#define IN(k) (lo <= (k) && (k) < hi)
#ifndef PROBE_MASK
#define PROBE_MASK 0
#endif
#if PROBE_MASK
#define STAMP(k) do { if (blockIdx.x == 0 && threadIdx.x == 0) *(LAS unsigned long long*)(lds + 146432 + 8 * ((k) + 1)) = __builtin_amdgcn_s_memrealtime(); } while (0)
#else
#define STAMP(k) do { } while (0)
#endif
#define SEAM(k) do { if (IN(k) && IN((k) + 1)) grid.sync(); STAMP(k); } while (0)
#define PH_BEGIN \
    int tid = threadIdx.x; asm volatile("" : "+v"(tid)); const int lane = tid & 63, wave = __builtin_amdgcn_readfirstlane(tid >> 6); \
    int G = gridDim.x, bid = blockIdx.x; asm volatile("" : "+s"(G), "+s"(bid)); \
    const int gw = bid * NWAVES + wave, NGW = G * NWAVES; const long gtid = (long)bid * NTHREADS + tid, NGT = (long)G * NTHREADS; \
    const unsigned char CAS* ka = (const unsigned char CAS*)__builtin_amdgcn_kernarg_segment_ptr(); asm volatile("" : "+s"(ka)); \
    unsigned char* ws = KA_PTR(unsigned char*, 168); float* out = KA_PTR(float*, 160); \
    bf16_t* HM = (bf16_t*)(ws + WS_HM); bf16_t* Wgu = (bf16_t*)(ws + WS_WFF); bf16_t* Wd = (bf16_t*)(ws + WS_WFF + OFF_WD); \
    bf16_t* WinT = (bf16_t*)(ws + WS_WM); bf16_t* WpaT = (bf16_t*)(ws + WS_WM + OFF_WPA); bf16_t* WppT = (bf16_t*)(ws + WS_WM + OFF_WPP); \
    bf16_t* WoutT = (bf16_t*)(ws + WS_WM + OFF_WOUT); bf16_t* WgT = (bf16_t*)(ws + WS_WM + OFF_WG); \
    bf16_t* XB = (bf16_t*)(ws + WS_XB); float* X1 = (float*)(ws + WS_X1); float* Z2 = (float*)(ws + WS_HM); \
    bf16_t* Dp = (bf16_t*)out; bf16_t* Pm = (bf16_t*)((unsigned char*)out + 32 * MiB); \
    LAS float* scr = (LAS float*)(lds + wave * 16640); \
    (void)lane; (void)gw; (void)NGW; (void)gtid; (void)NGT; (void)HM; (void)Wgu; (void)Wd; (void)WinT; (void)WpaT; (void)WppT; (void)WoutT; (void)WgT; (void)XB; (void)X1; (void)Z2; (void)Dp; (void)Pm; (void)scr;

    STAMP(-1);
    if (IN(0)) { PH_BEGIN
        {   int base = 0;
            base = run_tr(ARG_IN(1), Wgu, DM, FF, 1, 0, base, gw, NGW, scr, lane);
            base = run_tr(ARG_IN(2), Wgu, DM, FF, 2, 0, base, gw, NGW, scr, lane);
            base = run_tr(ARG_IN(3), Wd, FF, DM, 0, 0, base, gw, NGW, scr, lane);
            base = run_tr(ARG_IN(6), WinT, DM, INW, 0, 0, base, gw, NGW, scr, lane);
            base = run_tr(ARG_IN(10), WpaT, DM, DM, 0, 0, base, gw, NGW, scr, lane);
            base = run_tr(ARG_IN(11), WppT, 1024, DM, 0, 0, base, gw, NGW, scr, lane);
            base = run_tr(ARG_IN(12), WoutT, DM, DM, 0, 0, base, gw, NGW, scr, lane);
#pragma unroll 1
            for (int g = 0; g < 4; ++g) base = run_tr(ARG_IN(8) + (size_t)g * 65536, WgT, 256, 256, 0, g * 256, base, gw, NGW, scr, lane);
        }
        const float* x = ARG_IN(0);
        for (long i = gtid; i < (long)M * DM / 8; i += NGT) { const f32x4 a = ((const f32x4*)x)[2 * i], b = ((const f32x4*)x)[2 * i + 1];
            u32x4 o; o.x = pk2(a[0], a[1]); o.y = pk2(a[2], a[3]); o.z = pk2(b[0], b[1]); o.w = pk2(b[2], b[3]); ((u32x4*)XB)[i] = o; }
        __syncthreads();
    }
    SEAM(0);
    if (IN(1)) { PH_BEGIN
        pg8::Gemm g{XB, Wgu}; pg8::StaticOrder S; S.init(M, 2 * FF, G, bid);
        pg8::EpiSwiGLU E{HM, FF};
        pg8::gemm_phase<pg8::EpiSwiGLU, pg8::StaticOrder, true, true, DM, DM, DM, 0>(lds, g, S, E);
    }
    SEAM(1);
    if (IN(2)) { PH_BEGIN
        pg8::Gemm g{HM, Wd}; pg8::StaticOrder S; S.init(M, DM, G, bid);
        pg8::EpiResF32 E{ARG_IN(0), out, DM, ALPHA, 0.5f};
        pg8::gemm_phase<pg8::EpiResF32, pg8::StaticOrder, true, true, FF, FF, FF, 0>(lds, g, S, E);
    }
    SEAM(2);
    if (IN(3)) { PH_BEGIN
        f32x4 gv[8], bv[8];
#pragma unroll
        for (int j = 0; j < 8; ++j) { gv[j] = ((const f32x4*)ARG_IN(4) + lane)[64 * j]; bv[j] = ((const f32x4*)ARG_IN(5) + lane)[64 * j]; }
        for (int m = gw; m < M; m += NGW) ln_row(out + (size_t)m * DM, gv, bv, X1 + (size_t)m * DM, XB + (size_t)m * DM, lane);
    }
    SEAM(3);
    if (IN(4)) { PH_BEGIN
        pg8::Gemm g{XB, WinT}; pg8::StaticOrder S; S.init(M, INW, G, bid);
        pg8::EpiBf16Sig E{HM, INW, COL_GA / 256};
        pg8::gemm_phase<pg8::EpiBf16Sig, pg8::StaticOrder, true, true, DM, DM, DM, 0>(lds, g, S, E);
    }
    SEAM(4);
    if (IN(5)) { PH_BEGIN
        for (int u = bid; u < (SEQ / 64) * NKVH; u += G) att::attn_unit((LAS char*)lds, HM, ARG_IN(7), u & 3, u >> 2);
        for (int w = gw; w < 2048; w += NGW) { const int g = w & 3, tb = 2 * (w >> 2) + (lane >> 5), c8 = 32 * g + (lane & 31);
            if (g == 0) pool_item<1>(HM, Dp, tb, c8); else if (g == 1) pool_item<2>(HM, Dp, tb, c8); else if (g == 2) pool_item<4>(HM, Dp, tb, c8); else pool_item<8>(HM, Dp, tb, c8); }
        __syncthreads();
    }
    SEAM(5);
    if (IN(6)) { PH_BEGIN
        pg8::Gemm g{Dp, WgT}; pg8::StaticOrder S; S.init(M, 1024, G, bid);
        pg8::EpiColScale E{Pm, 1024, ARG_IN(9)};
        pg8::gemm_phase<pg8::EpiColScale, pg8::StaticOrder, true, true, 256, 1024, 256, 256>(lds, g, S, E);
    }
    SEAM(6);
    if (IN(7)) { PH_BEGIN
        {   pg8::Gemm g{HM, WpaT}; pg8::StaticOrder S; S.init(M, DM, G, bid);
            pg8::EpiGate<false> E{XB, DM, HM + COL_GA, INW};
            pg8::gemm_phase<pg8::EpiGate<false>, pg8::StaticOrder, true, true, DM, INW, DM, 0>(lds, g, S, E); }
        {   pg8::Gemm g{Pm, WppT}; pg8::StaticOrder S; S.init(M, DM, G, bid);
            pg8::EpiGate<true> E{XB, DM, HM + COL_GB, INW};
            pg8::gemm_phase<pg8::EpiGate<true>, pg8::StaticOrder, true, true, 1024, 1024, 1024, 0>(lds, g, S, E); }
    }
    SEAM(7);
    if (IN(8)) { PH_BEGIN
        pg8::Gemm g{XB, WoutT}; pg8::StaticOrder S; S.init(M, DM, G, bid);
        pg8::EpiResF32 E{X1, Z2, DM, ALPHA, 1.0f};
        pg8::gemm_phase<pg8::EpiResF32, pg8::StaticOrder, true, true, DM, DM, DM, 0>(lds, g, S, E);
    }
    SEAM(8);
    if (IN(9)) { PH_BEGIN
        {   f32x4 gv[8], bv[8];
#pragma unroll
            for (int j = 0; j < 8; ++j) { gv[j] = ((const f32x4*)ARG_IN(13) + lane)[64 * j]; bv[j] = ((const f32x4*)ARG_IN(14) + lane)[64 * j]; }
            for (int m = gw; m < M; m += NGW) ln_row(Z2 + (size_t)m * DM, gv, bv, X1 + (size_t)m * DM, XB + (size_t)m * DM, lane); }
        {   int base = 0;
            base = run_tr(ARG_IN(15), Wgu, DM, FF, 1, 0, base, gw, NGW, scr, lane);
            base = run_tr(ARG_IN(16), Wgu, DM, FF, 2, 0, base, gw, NGW, scr, lane);
            base = run_tr(ARG_IN(17), Wd, FF, DM, 0, 0, base, gw, NGW, scr, lane); }
        __syncthreads();
    }
    SEAM(9);
    if (IN(10)) { PH_BEGIN
        pg8::Gemm g{XB, Wgu}; pg8::StaticOrder S; S.init(M, 2 * FF, G, bid);
        pg8::EpiSwiGLU E{HM, FF};
        pg8::gemm_phase<pg8::EpiSwiGLU, pg8::StaticOrder, true, true, DM, DM, DM, 0>(lds, g, S, E);
    }
    SEAM(10);
    if (IN(11)) { PH_BEGIN
        pg8::Gemm g{HM, Wd}; pg8::StaticOrder S; S.init(M, DM, G, bid);
        pg8::EpiResF32 E{X1, out, DM, ALPHA, 0.5f};
        pg8::gemm_phase<pg8::EpiResF32, pg8::StaticOrder, true, true, FF, FF, FF, 0>(lds, g, S, E);
    }
    SEAM(11);
    if (IN(12)) { PH_BEGIN
        f32x4 gv[8], bv[8];
#pragma unroll
        for (int j = 0; j < 8; ++j) { gv[j] = ((const f32x4*)ARG_IN(18) + lane)[64 * j]; bv[j] = ((const f32x4*)ARG_IN(19) + lane)[64 * j]; }
        for (int m = gw; m < M; m += NGW) ln_row(out + (size_t)m * DM, gv, bv, out + (size_t)m * DM, nullptr, lane);
    }
#if PROBE_MASK
    STAMP(12);
    if (blockIdx.x == 0 && threadIdx.x == 0) { unsigned long long sum = 0;
        for (int k = 0; k < N_PHASES; ++k) if ((PROBE_MASK >> k) & 1) sum += *(LAS unsigned long long*)(lds + 146432 + 8 * (k + 1)) - *(LAS unsigned long long*)(lds + 146432 + 8 * k);
        const unsigned long long t0 = __builtin_amdgcn_s_memrealtime(); while (__builtin_amdgcn_s_memrealtime() - t0 < sum) __builtin_amdgcn_s_sleep(8); }
#endif
#undef IN
#undef SEAM
#undef PH_BEGIN
}

#ifndef MK_PER_PHASE
#define MK_PER_PHASE 0
#endif
extern "C" void kernel_launch(void* const* d_in, const int* in_sizes, int n_in, void* d_out, int out_size, void* d_ws, size_t ws_size, hipStream_t stream) {
    static int grid = 0;
    if (grid == 0) {
        if (n_in != 20 || in_sizes[0] != M * DM || out_size != M * DM || ws_size < WS_END) {
            fprintf(stderr, "kernel_launch: unexpected shapes: n_in %d in0 %d out %d ws %zu (need %zu)\n", n_in, n_in > 0 ? in_sizes[0] : -1, out_size, ws_size, (size_t)WS_END); grid = -1; return; }
        int dev = 0, cus = 0, per_cu = 0;
        hipGetDevice(&dev); hipDeviceGetAttribute(&cus, hipDeviceAttributeMultiprocessorCount, dev);
        if (hipFuncSetAttribute((const void*)fwd_mega, hipFuncAttributeMaxDynamicSharedMemorySize, LDS_BYTES) != hipSuccess) { fprintf(stderr, "kernel_launch: hipFuncSetAttribute failed\n"); grid = -1; return; }
        if (hipOccupancyMaxActiveBlocksPerMultiprocessor(&per_cu, (const void*)fwd_mega, NTHREADS, LDS_BYTES) != hipSuccess || per_cu < 1) { fprintf(stderr, "kernel_launch: occupancy query says %d\n", per_cu); per_cu = 1; }
        (void)hipGetLastError();
        grid = cus * 1;
    }
    if (grid < 0) return;
    Args a{};
    for (int i = 0; i < 20; ++i) a.in[i] = (const float*)d_in[i];
    a.out = (float*)d_out; a.ws = (unsigned char*)d_ws;
#if MK_PER_PHASE
    for (int p = 0; p < N_PHASES; ++p) { a.ph_lo = p; a.ph_hi = p + 1; hipLaunchKernelGGL(fwd_mega, dim3(grid), dim3(NTHREADS), LDS_BYTES, stream, a); }
#else
    a.ph_lo = 0; a.ph_hi = N_PHASES;
    void* kargs[] = {&a};
    hipError_t e = hipLaunchCooperativeKernel((const void*)fwd_mega, dim3(grid), dim3(NTHREADS), kargs, LDS_BYTES, stream);
    if (e != hipSuccess) fprintf(stderr, "kernel_launch: cooperative launch failed: %s (grid %d)\n", hipGetErrorString(e), grid);
#endif
}
```

```cpp
#include <hip/hip_runtime.h>
#include <hip/hip_cooperative_groups.h>
#include <cstdio>
#include <cstdint>
namespace cg = cooperative_groups;

namespace pg8 {
#define PG8_LAS __attribute__((address_space(3)))
typedef unsigned short bf16_t;
typedef short bf16x8 __attribute__((ext_vector_type(8)));
typedef float f32x4 __attribute__((ext_vector_type(4)));
typedef unsigned u32x4 __attribute__((ext_vector_type(4)));
constexpr int BM = 256, BK = 64, HALF = 128, HTB = HALF * BK * 2  , STAGE_BYTES = 8 * HTB, NXCD = 8, WGM = 8;

__host__ __device__ __forceinline__ int lds_byte(int r, int c) { const int st = (r >> 4) * 2 + (c >> 5), rr = r & 15, cc = c & 31, ob = rr * 64 + cc * 2; return st * 1024 + (ob ^ (((ob >> 9) & 1) << 5)); }
__host__ __device__ __forceinline__ void stage_rc(int b, int& R, int& C) { const int st = b / 1024, sb = b % 1024, swz = sb ^ (((sb >> 9) & 1) << 5); R = (st >> 1) * 16 + swz / 64; C = (st & 1) * 32 + (swz % 64) / 2; }
__host__ __device__ __forceinline__ int perm32(int rho) { const int n = rho >> 4, i = rho & 15; return 8 * (i >> 2) + 4 * n + (i & 3); }

struct Unit { int pm, pn; };
struct Gemm { const bf16_t* A; const bf16_t* Bt; };

struct StaticOrder {
    int nM, nN, nwg, G, c;
    __host__ __device__ void init(int M, int N, int G_, int c_) { nM = M / BM; nN = N / BM; nwg = nM * nN; G = G_; c = c_; }
    __host__ __device__ bool next(int i, Unit& u) const {
        const long L = (long)i * G + c; if (L >= nwg) return false;
        int wgid = (int)L; { const int q = nwg / NXCD, r = nwg % NXCD, xcd = wgid % NXCD, off = wgid / NXCD; wgid = (xcd < r ? xcd * (q + 1) : r * (q + 1) + (xcd - r) * q) + off; }
        const int nig = WGM * nN, gid = wgid / nig, fm = gid * WGM, gsz = (nM - fm) < WGM ? (nM - fm) : WGM;
        u.pm = fm + ((wgid % nig) % gsz); u.pn = (wgid % nig) / gsz; return true;
    }
    __device__ __forceinline__ void a_ready(const Unit&) const {}
    __device__ __forceinline__ void done(const Unit&) const {}
};


__device__ __forceinline__ unsigned cvt_pk_bf16(float lo, float hi) { unsigned r; asm volatile("v_cvt_pk_bf16_f32 %0, %1, %2" : "=v"(r) : "v"(lo), "v"(hi)); return r; }
__device__ __forceinline__ float sigm(float v) { return __builtin_amdgcn_rcpf(1.f + __builtin_amdgcn_exp2f(-1.4426950408889634f * v)); }
__device__ __forceinline__ float bf_lo(unsigned w) { return __uint_as_float(w << 16); }
__device__ __forceinline__ float bf_hi(unsigned w) { return __uint_as_float(w & 0xffff0000u); }
__device__ __forceinline__ u32x4 pack8(const f32x4 v0, const f32x4 v1) { u32x4 w; w.x = cvt_pk_bf16(v0[0], v0[1]); w.y = cvt_pk_bf16(v0[2], v0[3]); w.z = cvt_pk_bf16(v1[0], v1[1]); w.w = cvt_pk_bf16(v1[2], v1[3]); return w; }
__device__ __forceinline__ void unpack8(const u32x4 w, f32x4& v0, f32x4& v1) { v0 = (f32x4){bf_lo(w.x), bf_hi(w.x), bf_lo(w.y), bf_hi(w.y)}; v1 = (f32x4){bf_lo(w.z), bf_hi(w.z), bf_lo(w.w), bf_hi(w.w)}; }

struct EpiSwiGLU {
    static constexpr bool PERM = true, AFTER_DRAIN = false;
    bf16_t* O; int ldc;
    __device__ __forceinline__ void operator()(const f32x4 (&acc)[2][2][4][2], const Unit& u, int wr, int wc, int fr, int fq) const {
        const int row0 = u.pm * BM + wr * 64 + fr, col0 = u.pn * HALF + wc * 32 + 8 * fq;
#pragma unroll
        for (int ai = 0; ai < 2; ++ai)
#pragma unroll
            for (int m = 0; m < 4; ++m) { bf16_t* rowp = O + (size_t)(row0 + ai * HALF + m * 16) * ldc + col0;
                f32x4 h0, h1;
#pragma unroll
                for (int j = 0; j < 4; ++j) { const float g0 = acc[ai][0][m][0][j], g1 = acc[ai][0][m][1][j];
                    h0[j] = g0 * sigm(g0) * acc[ai][1][m][0][j]; h1[j] = g1 * sigm(g1) * acc[ai][1][m][1][j]; }
                *(u32x4*)rowp = pack8(h0, h1); }
    }
};
struct EpiBf16Sig {
    static constexpr bool PERM = true, AFTER_DRAIN = false;
    bf16_t* O; int ldc; int sig_from;
    __device__ __forceinline__ void operator()(const f32x4 (&acc)[2][2][4][2], const Unit& u, int wr, int wc, int fr, int fq) const {
        const int row0 = u.pm * BM + wr * 64 + fr, col0 = u.pn * BM + wc * 32 + 8 * fq; const bool sg = u.pn >= sig_from;
#pragma unroll
        for (int ai = 0; ai < 2; ++ai)
#pragma unroll
            for (int m = 0; m < 4; ++m) { bf16_t* rowp = O + (size_t)(row0 + ai * HALF + m * 16) * ldc + col0;
#pragma unroll
                for (int bj = 0; bj < 2; ++bj) { f32x4 v0 = acc[ai][bj][m][0], v1 = acc[ai][bj][m][1];
                    if (sg) {
#pragma unroll
                        for (int j = 0; j < 4; ++j) { v0[j] = sigm(v0[j]); v1[j] = sigm(v1[j]); } }
                    *(u32x4*)(rowp + bj * HALF) = pack8(v0, v1); } }
    }
};
struct EpiColScale {
    static constexpr bool PERM = true, AFTER_DRAIN = false;
    bf16_t* O; int ldc; const float* scale;
    __device__ __forceinline__ void operator()(const f32x4 (&acc)[2][2][4][2], const Unit& u, int wr, int wc, int fr, int fq) const {
        const int row0 = u.pm * BM + wr * 64 + fr, col0 = u.pn * BM + wc * 32 + 8 * fq;
        f32x4 sv[2][2];
#pragma unroll
        for (int bj = 0; bj < 2; ++bj)
#pragma unroll
            for (int n = 0; n < 2; ++n) sv[bj][n] = *(const f32x4*)(scale + col0 + bj * HALF + 4 * n);
#pragma unroll
        for (int ai = 0; ai < 2; ++ai)
#pragma unroll
            for (int m = 0; m < 4; ++m) { bf16_t* rowp = O + (size_t)(row0 + ai * HALF + m * 16) * ldc + col0;
#pragma unroll
                for (int bj = 0; bj < 2; ++bj) *(u32x4*)(rowp + bj * HALF) = pack8(acc[ai][bj][m][0] * sv[bj][0], acc[ai][bj][m][1] * sv[bj][1]); }
    }
};
template <bool ADD> struct EpiGate {
    static constexpr bool PERM = true, AFTER_DRAIN = false;
    bf16_t* O; int ldc; const bf16_t* G; int ldg;
    __device__ __forceinline__ void operator()(const f32x4 (&acc)[2][2][4][2], const Unit& u, int wr, int wc, int fr, int fq) const {
        const int row0 = u.pm * BM + wr * 64 + fr, col0 = u.pn * BM + wc * 32 + 8 * fq;
#pragma unroll
        for (int ai = 0; ai < 2; ++ai) {
            u32x4 gq[4][2], tq[4][2];
#pragma unroll
            for (int m = 0; m < 4; ++m) { const size_t r = (size_t)(row0 + ai * HALF + m * 16);
#pragma unroll
                for (int bj = 0; bj < 2; ++bj) { gq[m][bj] = *(const u32x4*)(G + r * ldg + col0 + bj * HALF); if (ADD) tq[m][bj] = *(const u32x4*)(O + r * ldc + col0 + bj * HALF); } }
#pragma unroll
            for (int m = 0; m < 4; ++m) { const size_t r = (size_t)(row0 + ai * HALF + m * 16);
#pragma unroll
                for (int bj = 0; bj < 2; ++bj) { f32x4 g0, g1; unpack8(gq[m][bj], g0, g1);
                    f32x4 v0 = acc[ai][bj][m][0] * g0, v1 = acc[ai][bj][m][1] * g1;
                    if (ADD) { f32x4 t0, t1; unpack8(tq[m][bj], t0, t1); v0 += t0; v1 += t1; }
                    *(u32x4*)(O + r * ldc + col0 + bj * HALF) = pack8(v0, v1); } }
            asm volatile("" ::: "memory"); }
    }
};
struct EpiResF32 {
    static constexpr bool PERM = false, AFTER_DRAIN = false;
    const float* res; float* out; int ldc; float ra, sa;
    __device__ __forceinline__ void operator()(const f32x4 (&acc)[2][2][4][2], const Unit& u, int wr, int wc, int fr, int fq) const {
        const int col0 = u.pn * BM + wc * 32 + 4 * fq;
#pragma unroll
        for (int ai = 0; ai < 2; ++ai) {
            f32x4 rs[4][2][2];
#pragma unroll
            for (int m = 0; m < 4; ++m) { const size_t off = (size_t)(u.pm * BM + ai * HALF + wr * 64 + m * 16 + fr) * ldc + col0;
#pragma unroll
                for (int bj = 0; bj < 2; ++bj)
#pragma unroll
                    for (int n = 0; n < 2; ++n) rs[m][bj][n] = *(const f32x4*)(res + off + bj * HALF + n * 16); }
#pragma unroll
            for (int m = 0; m < 4; ++m) { const size_t off = (size_t)(u.pm * BM + ai * HALF + wr * 64 + m * 16 + fr) * ldc + col0;
#pragma unroll
                for (int bj = 0; bj < 2; ++bj)
#pragma unroll
                    for (int n = 0; n < 2; ++n) *(f32x4*)(out + off + bj * HALF + n * 16) = rs[m][bj][n] * ra + acc[ai][bj][m][n] * sa; }
            asm volatile("" ::: "memory"); }
    }
};

struct EpiResLN {
    static constexpr bool PERM = false, AFTER_DRAIN = false;
    const float* z; const float* st; const float* g; const float* b; float* out; int ldc; float ra, sa;
    __device__ __forceinline__ void operator()(const f32x4 (&acc)[2][2][4][2], const Unit& u, int wr, int wc, int fr, int fq) const {
        typedef float f32x2v __attribute__((ext_vector_type(2)));
        const int col0 = u.pn * BM + wc * 32 + 4 * fq;
        f32x4 gv[2][2], bv[2][2];
#pragma unroll
        for (int bj = 0; bj < 2; ++bj)
#pragma unroll
            for (int n = 0; n < 2; ++n) { gv[bj][n] = *(const f32x4*)(g + col0 + bj * HALF + n * 16) * ra; bv[bj][n] = *(const f32x4*)(b + col0 + bj * HALF + n * 16) * ra; }
#pragma unroll
        for (int am = 0; am < 4; ++am) { const int ai = am >> 1, m0 = (am & 1) * 2;
            f32x4 rs[2][2][2]; f32x2v sv[2];
#pragma unroll
            for (int mm = 0; mm < 2; ++mm) { const int row = u.pm * BM + ai * HALF + wr * 64 + (m0 + mm) * 16 + fr; const size_t off = (size_t)row * ldc + col0;
                sv[mm] = *(const f32x2v*)(st + 2 * (size_t)row);
#pragma unroll
                for (int bj = 0; bj < 2; ++bj)
#pragma unroll
                    for (int n = 0; n < 2; ++n) rs[mm][bj][n] = *(const f32x4*)(z + off + bj * HALF + n * 16); }
#pragma unroll
            for (int mm = 0; mm < 2; ++mm) { const size_t off = (size_t)(u.pm * BM + ai * HALF + wr * 64 + (m0 + mm) * 16 + fr) * ldc + col0;
#pragma unroll
                for (int bj = 0; bj < 2; ++bj)
#pragma unroll
                    for (int n = 0; n < 2; ++n) *(f32x4*)(out + off + bj * HALF + n * 16) = ((rs[mm][bj][n] - sv[mm].x) * sv[mm].y) * gv[bj][n] + bv[bj][n] + acc[ai][bj][m0 + mm][n] * sa; }
            asm volatile("" ::: "memory"); }
    }
};

template <class Epi, class Sched, bool ALIGN_EPI, bool SP2, int K_, int LDA, int LDB, int ACOL>
__device__ __forceinline__ void gemm_phase(PG8_LAS unsigned char* lds, const Gemm g, const Sched& S, const Epi& E) {
    int tid = threadIdx.x; asm volatile("" : "+v"(tid)); const int wid = __builtin_amdgcn_readfirstlane(tid >> 6), lane = tid & 63, wr = wid >> 2, wc = wid & 3, fr = lane & 15, fq = lane >> 4;
    constexpr int K = K_, nt = K / BK; static_assert(K % 128 == 0 && K >= 256, "K");
    unsigned voffA[2], voffB[2];
#pragma unroll
    for (int i = 0; i < 2; ++i) { int R, C; stage_rc(tid * 16 + i * 8192, R, C); const int Rb = Epi::PERM ? ((R & ~31) + perm32(R & 31)) : R;
        voffA[i] = (unsigned)(R * LDA + C) * 2u; voffB[i] = (unsigned)(Rb * LDB + C) * 2u; }
    const size_t kstep = (size_t)(BK * 2);
    constexpr size_t hstepA = (size_t)HALF * LDA * 2, hstepB = (size_t)HALF * LDB * 2;
    constexpr size_t tstepA = 2 * hstepA, tstepB = 2 * hstepB, pnA = (size_t)ACOL * 2;
    const unsigned ldsw = (unsigned)wid * 1024u;
    const int aoff = lds_byte(wr * 64 + fr, fq * 8), boff = lds_byte(wc * 32 + fr, fq * 8);
#define PG8_SA(b, h) (((b) * 2 + (h)) * HTB)
#define PG8_SB(b, h) ((4 + (b) * 2 + (h)) * HTB)
#define PG8_STAGE(bufoff, gbase, voff) do { _Pragma("unroll") for (int _i = 0; _i < 2; ++_i) \
        __builtin_amdgcn_global_load_lds((const unsigned*)((const char*)(gbase) + (voff)[_i]), (PG8_LAS unsigned*)(lds + (bufoff) + ldsw + _i * 8192), 16, 0, 0); } while (0)
#define PG8_LDA(dst, b, h) do { _Pragma("unroll") for (int m = 0; m < 4; ++m) _Pragma("unroll") for (int k = 0; k < 2; ++k) dst[m][k] = *(const PG8_LAS bf16x8*)(lds + PG8_SA(b, h) + aoff + m * 2048 + k * 1024); } while (0)
#define PG8_LDB(dst, b, h) do { _Pragma("unroll") for (int n = 0; n < 2; ++n) _Pragma("unroll") for (int k = 0; k < 2; ++k) dst[n][k] = *(const PG8_LAS bf16x8*)(lds + PG8_SB(b, h) + boff + n * 2048 + k * 1024); } while (0)
#define PG8_MMA(ai, bj, At, Bt) do { __builtin_amdgcn_s_setprio(1); _Pragma("unroll") for (int m = 0; m < 4; ++m) _Pragma("unroll") for (int n = 0; n < 2; ++n) _Pragma("unroll") for (int k = 0; k < 2; ++k) \
        acc[ai][bj][m][n] = __builtin_amdgcn_mfma_f32_16x16x32_bf16(Bt[n][k], At[m][k], acc[ai][bj][m][n], 0, 0, 0); __builtin_amdgcn_s_setprio(0); } while (0)
#define PG8_WAIT_V(n) asm volatile("s_waitcnt vmcnt(" #n ")" ::: "memory")
#define PG8_WAIT_L(n) asm volatile("s_waitcnt lgkmcnt(" #n ")" ::: "memory")
#define PG8_BAR __builtin_amdgcn_s_barrier()
#define PG8_SCHED __builtin_amdgcn_sched_barrier(0)
    Unit cur, nxt; int ui = 0;
    if (!S.next(0, cur)) return;
    f32x4 acc[2][2][4][2];
#pragma unroll
    for (int a = 0; a < 2; ++a)
#pragma unroll
        for (int b = 0; b < 2; ++b)
#pragma unroll
            for (int m = 0; m < 4; ++m)
#pragma unroll
                for (int n = 0; n < 2; ++n) acc[a][b][m][n] = (f32x4){0.f, 0.f, 0.f, 0.f};
    bf16x8 At[4][2], B0[2][2], B1[2][2];
    const char* cA = (const char*)g.A + (size_t)cur.pm * tstepA + (size_t)cur.pn * pnA; const char* cB = (const char*)g.Bt + (size_t)cur.pn * tstepB;
    S.a_ready(cur);
    if constexpr (SP2) {
        PG8_STAGE(PG8_SB(0, 0), cB, voffB); PG8_STAGE(PG8_SB(0, 1), cB + hstepB, voffB); PG8_STAGE(PG8_SA(0, 0), cA, voffA); PG8_STAGE(PG8_SA(0, 1), cA + hstepA, voffA);
        if (wr == 1) PG8_BAR;
        PG8_WAIT_V(2); PG8_BAR;
        PG8_STAGE(PG8_SB(1, 0), cB + kstep, voffB); PG8_STAGE(PG8_SA(1, 0), cA + kstep, voffA); PG8_STAGE(PG8_SB(1, 1), cB + hstepB + kstep, voffB);
        PG8_WAIT_V(6); PG8_BAR;
    } else {
        PG8_STAGE(PG8_SB(0, 0), cB, voffB); PG8_STAGE(PG8_SA(0, 0), cA, voffA); PG8_STAGE(PG8_SB(0, 1), cB + hstepB, voffB); PG8_STAGE(PG8_SA(0, 1), cA + hstepA, voffA);
        if (wr == 1) PG8_BAR;
        PG8_WAIT_V(4); PG8_BAR;
        PG8_STAGE(PG8_SB(1, 0), cB + kstep, voffB); PG8_STAGE(PG8_SA(1, 0), cA + kstep, voffA); PG8_STAGE(PG8_SB(1, 1), cB + hstepB + kstep, voffB);
        PG8_WAIT_V(6); PG8_BAR;
    }
    for (;;) {
        const bool has_next = S.next(ui + 1, nxt);
        const char* nA = has_next ? (const char*)g.A + (size_t)nxt.pm * tstepA + (size_t)nxt.pn * pnA : cA; const char* nB = has_next ? (const char*)g.Bt + (size_t)nxt.pn * tstepB : cB;
        for (int t = 0; t < nt; t += 2) {
            const bool last = (t == nt - 2);
            const char* a1 = cA + (size_t)(t + 1) * kstep;
            const char* a2 = last ? nA : cA + (size_t)(t + 2) * kstep; const char* b2 = last ? nB : cB + (size_t)(t + 2) * kstep;
            const char* a3 = a2 + kstep; const char* b3 = b2 + kstep;
            if (last && has_next) S.a_ready(nxt);
            if constexpr (SP2) {
            PG8_LDB(B0, 0, 0); PG8_LDB(B1, 0, 1); PG8_SCHED; PG8_LDA(At, 0, 0); PG8_STAGE(PG8_SA(1, 1), a1 + hstepA, voffA);
            PG8_WAIT_V(8); PG8_WAIT_L(0); PG8_BAR; PG8_MMA(0, 0, At, B0); PG8_MMA(0, 1, At, B1); PG8_BAR; PG8_SCHED;
            PG8_LDA(At, 0, 1); PG8_STAGE(PG8_SB(0, 0), b2, voffB); PG8_STAGE(PG8_SB(0, 1), b2 + hstepB, voffB); PG8_STAGE(PG8_SA(0, 0), a2, voffA);
            PG8_WAIT_V(8); PG8_WAIT_L(0); PG8_BAR; PG8_MMA(1, 0, At, B0); PG8_MMA(1, 1, At, B1); PG8_BAR; PG8_SCHED;
            PG8_LDB(B0, 1, 0); PG8_LDB(B1, 1, 1); PG8_SCHED; PG8_LDA(At, 1, 0); PG8_STAGE(PG8_SA(0, 1), a2 + hstepA, voffA);
            PG8_WAIT_V(8); PG8_WAIT_L(0); PG8_BAR; PG8_MMA(0, 0, At, B0); PG8_MMA(0, 1, At, B1); PG8_BAR; PG8_SCHED;
            PG8_LDA(At, 1, 1); PG8_STAGE(PG8_SB(1, 0), b3, voffB); PG8_STAGE(PG8_SB(1, 1), b3 + hstepB, voffB); PG8_STAGE(PG8_SA(1, 0), a3, voffA);
            PG8_WAIT_V(8); PG8_WAIT_L(0); PG8_BAR; PG8_MMA(1, 0, At, B0); PG8_MMA(1, 1, At, B1); PG8_BAR; PG8_SCHED;
            } else {
            PG8_LDB(B0, 0, 0); PG8_SCHED; PG8_LDA(At, 0, 0); PG8_STAGE(PG8_SA(1, 1), a1 + hstepA, voffA);
            PG8_WAIT_L(8); PG8_BAR; PG8_WAIT_L(0); PG8_MMA(0, 0, At, B0); PG8_BAR; PG8_SCHED;
            PG8_LDB(B1, 0, 1); PG8_STAGE(PG8_SB(0, 0), b2, voffB);
            PG8_BAR; PG8_WAIT_L(0); PG8_MMA(0, 1, At, B1); PG8_BAR;
            PG8_LDA(At, 0, 1); PG8_STAGE(PG8_SA(0, 0), a2, voffA);
            PG8_BAR; PG8_WAIT_L(0); PG8_MMA(1, 0, At, B0); PG8_BAR; PG8_SCHED;
            PG8_STAGE(PG8_SB(0, 1), b2 + hstepB, voffB);
            PG8_WAIT_V(6); PG8_BAR; PG8_MMA(1, 1, At, B1); PG8_BAR;
            PG8_LDB(B0, 1, 0); PG8_SCHED; PG8_LDA(At, 1, 0); PG8_STAGE(PG8_SA(0, 1), a2 + hstepA, voffA);
            PG8_WAIT_L(8); PG8_BAR; PG8_WAIT_L(0); PG8_MMA(0, 0, At, B0); PG8_BAR; PG8_SCHED;
            PG8_LDB(B1, 1, 1); PG8_STAGE(PG8_SB(1, 0), b3, voffB);
            PG8_BAR; PG8_WAIT_L(0); PG8_MMA(0, 1, At, B1); PG8_BAR;
            PG8_LDA(At, 1, 1); PG8_STAGE(PG8_SA(1, 0), a3, voffA);
            PG8_BAR; PG8_WAIT_L(0); PG8_MMA(1, 0, At, B0); PG8_BAR; PG8_SCHED;
            PG8_STAGE(PG8_SB(1, 1), b3 + hstepB, voffB);
            PG8_WAIT_V(6); PG8_BAR; PG8_MMA(1, 1, At, B1); PG8_BAR;
            }
        }
        if constexpr (ALIGN_EPI) { if (wr == 0) PG8_BAR; }
        if constexpr (!Epi::AFTER_DRAIN) { E(acc, cur, wr, wc, fr, fq); S.done(cur); }
        if (!has_next) break;
#pragma unroll
        for (int a = 0; a < 2; ++a)
#pragma unroll
            for (int b = 0; b < 2; ++b)
#pragma unroll
                for (int m = 0; m < 4; ++m)
#pragma unroll
                    for (int n = 0; n < 2; ++n) acc[a][b][m][n] = (f32x4){0.f, 0.f, 0.f, 0.f};
        cur = nxt; cA = nA; cB = nB; ++ui;
        if constexpr (ALIGN_EPI) { if (wr == 1) PG8_BAR; }
    }
    PG8_WAIT_V(0);
    if constexpr (!ALIGN_EPI) { if (wr == 0) PG8_BAR; }
    PG8_BAR;
    if constexpr (Epi::AFTER_DRAIN) { E.fused(acc, cur, wr, wc, fr, fq, lds, wid, lane); S.done(cur); }
#undef PG8_SA
#undef PG8_SB
#undef PG8_STAGE
#undef PG8_LDA
#undef PG8_LDB
#undef PG8_MMA
#undef PG8_WAIT_V
#undef PG8_WAIT_L
#undef PG8_BAR
#undef PG8_SCHED
}
}

#define LAS __attribute__((address_space(3)))
typedef unsigned short bf16_t;
typedef float f32x4 __attribute__((ext_vector_type(4)));
typedef unsigned u32x4 __attribute__((ext_vector_type(4)));
constexpr int M = 16384, DM = 2048, FF = 5632, INW = 8192, SEQ = 16384;
constexpr int NQH = 16, NKVH = 4, HD = 128;
constexpr int COL_K = 2048, COL_V = 2560, COL_P = 3072, COL_GA = 4096, COL_GB = 6144;
constexpr float ALPHA = 1.189207115002721f;
constexpr float LN_EPS = 1e-5f;

namespace att {
using bf16x8 = __attribute__((ext_vector_type(8))) short;
using s16x4  = __attribute__((ext_vector_type(4))) short;
using f32x16 = __attribute__((ext_vector_type(16))) float;
#define KSWZ(row, colB) ((row) * 256 + ((colB) ^ (((row) & 7) << 4)))
#define SBAR() __builtin_amdgcn_sched_barrier(0)
__device__ __forceinline__ int crow(int r, int hi) { return (r & 3) + 8 * (r >> 2) + 4 * hi; }
__device__ __forceinline__ unsigned cvtpk(float lo, float hi) { unsigned r; asm volatile("v_cvt_pk_bf16_f32 %0, %1, %2" : "=v"(r) : "v"(lo), "v"(hi)); return r; }
__device__ __forceinline__ int v_st(int k, int c) { const int kk = (k & ~0xC) | ((k & 4) << 1) | ((k & 8) >> 1); return ((kk >> 3) * 4 + (c >> 5)) * 512 + ((kk & 7) * 32 + (c & 31)) * 2; }
__device__ __forceinline__ int v_rd_base(int lane) { return ((lane & 3) << 3) | (((lane >> 2) & 3) << 6) | (((lane >> 4) & 1) << 5) | (((lane >> 5) & 1) << 8); }
constexpr int v_rd_off(int d0, int ks, int half) { return d0 * 512 + ks * 4096 + half * 2048; }
template <int OFF> __device__ __forceinline__ s16x4 tr_read(int vb) {
  s16x4 r; asm volatile("ds_read_b64_tr_b16 %0, %1 offset:%2" : "=&v"(r) : "v"(vb), "i"(OFF) : "memory"); return r;
}
template <int D0> __device__ __forceinline__ void pv_one(f32x16& od, int vb, bf16x8 pa0, bf16x8 pa1, bf16x8 pa2, bf16x8 pa3) {
  const s16x4 l0 = tr_read<v_rd_off(D0, 0, 0)>(vb), h0 = tr_read<v_rd_off(D0, 0, 1)>(vb), l1 = tr_read<v_rd_off(D0, 1, 0)>(vb), h1 = tr_read<v_rd_off(D0, 1, 1)>(vb);
  const s16x4 l2 = tr_read<v_rd_off(D0, 2, 0)>(vb), h2 = tr_read<v_rd_off(D0, 2, 1)>(vb), l3 = tr_read<v_rd_off(D0, 3, 0)>(vb), h3 = tr_read<v_rd_off(D0, 3, 1)>(vb);
  asm volatile("s_waitcnt lgkmcnt(0)" ::: "memory"); SBAR();
#define PK(L, H) (bf16x8){L[0], L[1], L[2], L[3], H[0], H[1], H[2], H[3]}
  od = __builtin_amdgcn_mfma_f32_32x32x16_bf16(pa0, PK(l0, h0), od, 0, 0, 0);
  od = __builtin_amdgcn_mfma_f32_32x32x16_bf16(pa1, PK(l1, h1), od, 0, 0, 0);
  od = __builtin_amdgcn_mfma_f32_32x32x16_bf16(pa2, PK(l2, h2), od, 0, 0, 0);
  od = __builtin_amdgcn_mfma_f32_32x32x16_bf16(pa3, PK(l3, h3), od, 0, 0, 0);
#undef PK
}
__device__ __forceinline__ void qkt(f32x16& p0, f32x16& p1, const LAS char* Ks, const bf16x8* qr, int r32, int hi) {
  p0 = f32x16{}; p1 = f32x16{};
#pragma unroll
  for (int d0 = 0; d0 < 8; ++d0) { const int cb = (d0 * 16 + hi * 8) * 2;
    const bf16x8 b0 = *(const LAS bf16x8*)(Ks + KSWZ(r32, cb));
    const bf16x8 b1 = *(const LAS bf16x8*)(Ks + KSWZ(32 + r32, cb));
    p0 = __builtin_amdgcn_mfma_f32_32x32x16_bf16(b0, qr[d0], p0, 0, 0, 0);
    p1 = __builtin_amdgcn_mfma_f32_32x32x16_bf16(b1, qr[d0], p1, 0, 0, 0); }
}
constexpr int ATT_BUF = 32768, ATT_SCR = 65536, ATT_OST = 67584, ATT_LDS = ATT_OST + 8 * 8192;

__device__ __forceinline__ void attn_unit(LAS char* lds, bf16_t* HMq, const float* __restrict__ sink, int kvh, int qb) {
  int tid = threadIdx.x; asm volatile("" : "+v"(tid)); const int wid = tid >> 6, lane = tid & 63, r32 = lane & 31, hi = lane >> 5;
  LAS float* wsf = (LAS float*)(lds + ATT_SCR) + wid * 64; LAS float* al_l = wsf; LAS float* li_l = wsf + 32;
  LAS char* ost = lds + ATT_OST + wid * 8192;
  const int hq = kvh * 4 + (wid >> 1), t0 = qb * 64, trow0 = t0 + 32 * (wid & 1), tq = trow0 + r32;
  constexpr float LOG2E = 1.4426950408889634f, C = 0.088388347648318440f * LOG2E, NEG = -1e30f;
  const int jlo = t0 < 128 ? (128 - t0) >> 6 : 0, jhi = (SEQ + 128 - t0) >> 6 < 5 ? (SEQ + 128 - t0) >> 6 : 5;
  const int sr = tid >> 4, sc = (tid & 15) * 8, vst0 = v_st(sr, sc), vst1 = v_st(32 + sr, sc), kst0 = KSWZ(sr, sc * 2), kst1 = KSWZ(32 + sr, sc * 2);
  const bf16_t* kvp = HMq + COL_K + kvh * HD + sc;
  bf16x8 k0v, k1v, v0v, v1v;
#define ATT_LOAD(j) do { const bf16_t* kr0 = kvp + (size_t)(t0 - 128 + 64 * (j) + sr) * INW; const bf16_t* kr1 = kr0 + (size_t)32 * INW; \
    k0v = *(const bf16x8*)kr0; k1v = *(const bf16x8*)kr1; v0v = *(const bf16x8*)(kr0 + (COL_V - COL_K)); v1v = *(const bf16x8*)(kr1 + (COL_V - COL_K)); } while (0)
  ATT_LOAD(jlo);
  bf16x8 qr[8];
  { const bf16_t* Qw = HMq + (size_t)tq * INW + hq * HD + hi * 8;
#pragma unroll
    for (int d0 = 0; d0 < 8; ++d0) qr[d0] = *(const bf16x8*)(Qw + d0 * 16); }
  const float slope2 = __builtin_amdgcn_exp2f(-0.5f * (float)(hq + 1)) * LOG2E;
  float m_reg = sink[hq] * LOG2E, l_reg = 1.f;
  f32x16 o[4];
#pragma unroll
  for (int d = 0; d < 4; ++d) o[d] = f32x16{};
  int cur = 0;
  for (int j = jlo; j < jhi; ++j) {
    LAS char* V_lds = lds + cur * ATT_BUF; LAS char* K_lds = V_lds + 16384;
    *(LAS bf16x8*)(V_lds + vst0) = v0v; *(LAS bf16x8*)(V_lds + vst1) = v1v; *(LAS bf16x8*)(K_lds + kst0) = k0v; *(LAS bf16x8*)(K_lds + kst1) = k1v;
    __syncthreads();
    if (j + 1 < jhi) ATT_LOAD(j + 1);
    const int vb0 = (int)(uintptr_t)V_lds + v_rd_base(lane);
    f32x16 p0, p1;
    qkt(p0, p1, K_lds, qr, r32, hi);
    const float fd = (float)(tq - (t0 - 128 + 64 * j) - 4 * hi);
    float pmax = NEG;
#pragma unroll
    for (int r = 0; r < 16; ++r) { const float cr = (float)((r & 3) + 8 * (r >> 2));
      const float d0 = fabsf(fd - cr), d1 = fabsf(fd - cr - 32.f);
      const float s0 = fmaf(p0[r], C, -slope2 * d0), s1 = fmaf(p1[r], C, -slope2 * d1);
      p0[r] = d0 <= 128.f ? s0 : NEG; p1[r] = d1 <= 128.f ? s1 : NEG;
      pmax = fmaxf(pmax, fmaxf(p0[r], p1[r])); }
    { auto rr = __builtin_amdgcn_permlane32_swap(__float_as_uint(pmax), __float_as_uint(pmax), false, false);
      pmax = fmaxf(__uint_as_float(rr[0]), __uint_as_float(rr[1])); }
    const float mn = fmaxf(m_reg, pmax), alpha = __builtin_amdgcn_exp2f(m_reg - mn); m_reg = mn;
    float ps = 0.f;
#pragma unroll
    for (int r = 0; r < 16; ++r) { p0[r] = __builtin_amdgcn_exp2f(p0[r] - mn); p1[r] = __builtin_amdgcn_exp2f(p1[r] - mn); ps += p0[r] + p1[r]; }
    { auto rr = __builtin_amdgcn_permlane32_swap(__float_as_uint(ps), __float_as_uint(ps), false, false);
      ps = __uint_as_float(rr[0]) + __uint_as_float(rr[1]); }
    l_reg = l_reg * alpha + ps;
    if (hi == 0) al_l[r32] = alpha;
    asm volatile("s_waitcnt lgkmcnt(0)" ::: "memory");
#pragma unroll
    for (int r = 0; r < 16; ++r) { const float a = al_l[crow(r, hi)];
#pragma unroll
      for (int d = 0; d < 4; ++d) o[d][r] *= a; }
    bf16x8 pa0, pa1, pa2, pa3;
#define PK4(P, BASE, OUT) do { unsigned a0 = cvtpk(P[BASE + 0], P[BASE + 1]), a1 = cvtpk(P[BASE + 2], P[BASE + 3]);   \
    unsigned b0 = cvtpk(P[BASE + 4], P[BASE + 5]), b1 = cvtpk(P[BASE + 6], P[BASE + 7]);                              \
    auto r0 = __builtin_amdgcn_permlane32_swap(a0, b0, false, false); auto r1 = __builtin_amdgcn_permlane32_swap(a1, b1, false, false); \
    u32x4 w = {r0[0], r1[0], r0[1], r1[1]}; OUT = *reinterpret_cast<bf16x8*>(&w); } while (0)
    PK4(p0, 0, pa0); PK4(p0, 8, pa1); PK4(p1, 0, pa2); PK4(p1, 8, pa3);
#undef PK4
    pv_one<0>(o[0], vb0, pa0, pa1, pa2, pa3); pv_one<1>(o[1], vb0, pa0, pa1, pa2, pa3); pv_one<2>(o[2], vb0, pa0, pa1, pa2, pa3); pv_one<3>(o[3], vb0, pa0, pa1, pa2, pa3);
    cur ^= 1;
  }
#undef ATT_LOAD
  if (hi == 0) li_l[r32] = l_reg;
  asm volatile("s_waitcnt lgkmcnt(0)" ::: "memory");
#pragma unroll
  for (int r = 0; r < 16; ++r) { const int orow = crow(r, hi); const float rl = __builtin_amdgcn_rcpf(li_l[orow]);
#pragma unroll
    for (int d0 = 0; d0 < 4; ++d0) *(LAS unsigned short*)(ost + orow * 256 + (d0 * 32 + r32) * 2) = (unsigned short)(cvtpk(o[d0][r] * rl, 0.f) & 0xffffu); }
  asm volatile("s_waitcnt lgkmcnt(0)" ::: "memory");
  bf16_t* Ow = HMq + (size_t)trow0 * INW + hq * HD;
#pragma unroll
  for (int i = 0; i < 8; ++i) { const int id = i * 64 + lane, row = id >> 4, ch = id & 15;
    *(u32x4*)(Ow + (size_t)row * INW + ch * 8) = *(const LAS u32x4*)(ost + row * 256 + ch * 16); }
  __syncthreads();
}
}


template <int HW> __device__ __forceinline__ void pool_item(const bf16_t* __restrict__ HMp, bf16_t* __restrict__ Dp, int tb, int c8) {
    constexpr int NR = 16 + 2 * HW;
    const int t0 = tb * 16; const bf16_t* pp = HMp + COL_P + c8 * 8;
    u32x4 R[NR];
#pragma unroll
    for (int k = 0; k < NR; ++k) { const int t = t0 - HW + k; R[k] = (t >= 0 && t < SEQ) ? *(const u32x4*)(pp + (size_t)t * INW) : (u32x4){0u, 0u, 0u, 0u}; }
    f32x4 Sa = {0.f, 0.f, 0.f, 0.f}, Sb = {0.f, 0.f, 0.f, 0.f};
#pragma unroll
    for (int k = 0; k < 2 * HW; ++k) { f32x4 a, b; pg8::unpack8(R[k], a, b); Sa += a; Sb += b; }
#pragma unroll
    for (int i = 0; i < 16; ++i) { const int t = t0 + i; const int lo = t - HW < 0 ? 0 : t - HW, hi = t + HW > SEQ ? SEQ : t + HW;
        const float inv = 1.f / (float)(hi - lo);
        f32x4 a, b; pg8::unpack8(R[i + HW], a, b);
        *(u32x4*)(Dp + (size_t)t * 1024 + c8 * 8) = pg8::pack8(Sa * inv - a, Sb * inv - b);
        if (i < 15) { f32x4 na, nb, oa, ob; pg8::unpack8(R[i + 2 * HW], na, nb); pg8::unpack8(R[i], oa, ob); Sa += na - oa; Sb += nb - ob; } }
}

constexpr size_t MiB = 1u << 20;
constexpr size_t WS_HM = 0;
constexpr size_t WS_WFF = 176 * MiB;
constexpr size_t WS_WM = 256 * MiB;
constexpr size_t WS_XB = 310 * MiB;
constexpr size_t WS_X1 = 374 * MiB;
constexpr size_t WS_ST1 = 502 * MiB, WS_ST2 = 503 * MiB;
constexpr size_t WS_END = 504 * MiB;
constexpr size_t OFF_WD = (size_t)2 * FF * DM * 2;
constexpr size_t OFF_WPA = (size_t)INW * DM * 2, OFF_WPP = OFF_WPA + (size_t)DM * DM * 2, OFF_WOUT = OFF_WPP + (size_t)DM * 1024 * 2, OFF_WG = OFF_WOUT + (size_t)DM * DM * 2;
static_assert(WS_WFF + OFF_WD + (size_t)DM * FF * 2 <= WS_WM && (size_t)M * FF * 2 <= WS_WFF && WS_WM + OFF_WG + 1024 * 256 * 2 <= WS_XB, "ws map");

constexpr int NWAVES = 8, NTHREADS = 512;
constexpr int LDS_BYTES = 147456;

__device__ __forceinline__ unsigned f2bf(float f) { unsigned u = __builtin_bit_cast(unsigned, f); return (u + 0x7fffu + ((u >> 16) & 1u)) >> 16; }
__device__ __forceinline__ unsigned pk2(float lo, float hi) { return f2bf(lo) | (f2bf(hi) << 16); }
__device__ __forceinline__ float wave_sum(float v) {
#pragma unroll
    for (int o = 1; o < 64; o <<= 1) v += __shfl_xor(v, o);
    return v;
}
__device__ __forceinline__ void tr_item(const float* __restrict__ W, int K, int N, bf16_t* WT, int mode, int row_off, LAS float* scr, int item, int lane) {
    const int nblk = N >> 6, kb = item / nblk, nb = item - kb * nblk, k0 = kb << 6, n0 = nb << 6;
    const int orow0 = mode == 0 ? row_off + n0 : ((n0 >> 7) << 8) + (n0 & 127) + (mode == 2 ? 128 : 0);
    const int lc = (lane & 15) * 4, lr = lane >> 4;
#pragma unroll
    for (int i = 0; i < 16; ++i) { const int k = 4 * i + lr; const f32x4 v = *(const f32x4*)(W + (size_t)(k0 + k) * N + n0 + lc);
        LAS float* s = scr + k * 65 + lc; s[0] = v[0]; s[1] = v[1]; s[2] = v[2]; s[3] = v[3]; }
    asm volatile("s_waitcnt lgkmcnt(0)" ::: "memory");
    const int kc = lane & 7;
#pragma unroll
    for (int j = 0; j < 8; ++j) { const int n = 8 * j + (lane >> 3); const LAS float* s = scr + (8 * kc) * 65 + n;
        u32x4 o; o.x = pk2(s[0 * 65], s[1 * 65]); o.y = pk2(s[2 * 65], s[3 * 65]); o.z = pk2(s[4 * 65], s[5 * 65]); o.w = pk2(s[6 * 65], s[7 * 65]);
        *(u32x4*)(WT + (size_t)(orow0 + n) * K + k0 + 8 * kc) = o; }
    asm volatile("s_waitcnt lgkmcnt(0)" ::: "memory");
}
__device__ __forceinline__ int run_tr(const float* W, bf16_t* WT, int K, int N, int mode, int row_off, int base, int gw, int NGW, LAS float* scr, int lane) {
    const int ni = (K >> 6) * (N >> 6);
    int st = gw - base; if (st < 0) st += NGW;
    for (int it = st; it < ni; it += NGW) tr_item(W, K, N, WT, mode, row_off, scr, it, lane);
    return (base + ni) % NGW;
}

__device__ __forceinline__ void ln_row(const float* zrow, const f32x4 (&gv)[8], const f32x4 (&bv)[8], float* xo, bf16_t* xb, float* st, int lane) {
    const f32x4* zr = (const f32x4*)zrow + lane;
    f32x4 v[8]; float s = 0.f;
#pragma unroll
    for (int j = 0; j < 8; ++j) { v[j] = zr[64 * j]; s += (v[j][0] + v[j][1]) + (v[j][2] + v[j][3]); }
    const float mean = wave_sum(s) * (1.f / DM); float s2 = 0.f;
#pragma unroll
    for (int j = 0; j < 8; ++j) { v[j] = v[j] - mean; s2 += (v[j][0] * v[j][0] + v[j][1] * v[j][1]) + (v[j][2] * v[j][2] + v[j][3] * v[j][3]); }
    const float rstd = 1.f / sqrtf(wave_sum(s2) * (1.f / DM) + LN_EPS);
    if (st && lane == 0) { st[0] = mean; st[1] = rstd; }
#pragma unroll
    for (int j = 0; j < 8; ++j) { const f32x4 y = v[j] * rstd * gv[j] + bv[j];
        if (xo) ((f32x4*)xo + lane)[64 * j] = y;
        if (xb) ((unsigned long long*)xb + lane)[64 * j] = (unsigned long long)pk2(y[0], y[1]) | ((unsigned long long)pk2(y[2], y[3]) << 32); }
}

struct Args { const float* in[20]; float* out; unsigned char* ws; int ph_lo, ph_hi; };
static_assert(sizeof(Args) == 184, "kernarg layout");
constexpr int N_PHASES = 13;

__global__ void __launch_bounds__(NTHREADS, 2) fwd_mega(Args args) {
    extern __shared__ __attribute__((aligned(16))) unsigned char lds_raw[];
    LAS unsigned char* lds = (LAS unsigned char*)lds_raw;
    cg::grid_group grid = cg::this_grid();
    __builtin_assume(__builtin_amdgcn_workitem_id_y() == 0); __builtin_assume(__builtin_amdgcn_workitem_id_z() == 0);
#define CAS __attribute__((address_space(4)))
#define KA_PTR(T, off) (*(T const CAS*)(ka + (off)))
#define ARG_IN(i) KA_PTR(const float*, 8 * (i))
    int lo, hi; { const unsigned char CAS* ka = (const unsigned char CAS*)__builtin_amdgcn_kernarg_segment_ptr(); lo = KA_PTR(int, 176); hi = KA_PTR(int, 180); }
#define IN(k) (lo <= (k) && (k) < hi)
#ifndef PROBE_MASK
#define PROBE_MASK 0
#endif
#if PROBE_MASK
#define STAMP(k) do { if (blockIdx.x == 0 && threadIdx.x == 0) *(LAS unsigned long long*)(lds + 146432 + 8 * ((k) + 1)) = __builtin_amdgcn_s_memrealtime(); } while (0)
#else
#define STAMP(k) do { } while (0)
#endif
#define SEAM(k) do { if (IN(k) && IN((k) + 1)) grid.sync(); STAMP(k); } while (0)
#define PH_BEGIN \
    int tid = threadIdx.x; asm volatile("" : "+v"(tid)); const int lane = tid & 63, wave = __builtin_amdgcn_readfirstlane(tid >> 6); \
    int G = gridDim.x, bid = blockIdx.x; asm volatile("" : "+s"(G), "+s"(bid)); \
    const int gw = bid * NWAVES + wave, NGW = G * NWAVES; const long gtid = (long)bid * NTHREADS + tid, NGT = (long)G * NTHREADS; \
    const unsigned char CAS* ka = (const unsigned char CAS*)__builtin_amdgcn_kernarg_segment_ptr(); asm volatile("" : "+s"(ka)); \
    unsigned char* ws = KA_PTR(unsigned char*, 168); float* out = KA_PTR(float*, 160); \
    bf16_t* HM = (bf16_t*)(ws + WS_HM); bf16_t* Wgu = (bf16_t*)(ws + WS_WFF); bf16_t* Wd = (bf16_t*)(ws + WS_WFF + OFF_WD); \
    bf16_t* WinT = (bf16_t*)(ws + WS_WM); bf16_t* WpaT = (bf16_t*)(ws + WS_WM + OFF_WPA); bf16_t* WppT = (bf16_t*)(ws + WS_WM + OFF_WPP); \
    bf16_t* WoutT = (bf16_t*)(ws + WS_WM + OFF_WOUT); bf16_t* WgT = (bf16_t*)(ws + WS_WM + OFF_WG); \
    bf16_t* XB = (bf16_t*)(ws + WS_XB); float* Z2 = (float*)(ws + WS_X1); float* ST1 = (float*)(ws + WS_ST1); float* ST2 = (float*)(ws + WS_ST2); \
    bf16_t* Dp = (bf16_t*)(ws + WS_X1); bf16_t* Pm = (bf16_t*)(ws + WS_X1 + 32 * MiB); \
    LAS float* scr = (LAS float*)(lds + wave * 16640); \
    (void)lane; (void)gw; (void)NGW; (void)gtid; (void)NGT; (void)HM; (void)Wgu; (void)Wd; (void)WinT; (void)WpaT; (void)WppT; (void)WoutT; (void)WgT; (void)XB; (void)ST1; (void)ST2; (void)Z2; (void)Dp; (void)Pm; (void)scr;

    STAMP(-1);
    if (IN(0)) { PH_BEGIN
        {   int base = 0;
            base = run_tr(ARG_IN(1), Wgu, DM, FF, 1, 0, base, gw, NGW, scr, lane);
            base = run_tr(ARG_IN(2), Wgu, DM, FF, 2, 0, base, gw, NGW, scr, lane);
            base = run_tr(ARG_IN(3), Wd, FF, DM, 0, 0, base, gw, NGW, scr, lane);
            base = run_tr(ARG_IN(6), WinT, DM, INW, 0, 0, base, gw, NGW, scr, lane);
            base = run_tr(ARG_IN(10), WpaT, DM, DM, 0, 0, base, gw, NGW, scr, lane);
            base = run_tr(ARG_IN(11), WppT, 1024, DM, 0, 0, base, gw, NGW, scr, lane);
            base = run_tr(ARG_IN(12), WoutT, DM, DM, 0, 0, base, gw, NGW, scr, lane);
#pragma unroll 1
            for (int g = 0; g < 4; ++g) base = run_tr(ARG_IN(8) + (size_t)g * 65536, WgT, 256, 256, 0, g * 256, base, gw, NGW, scr, lane);
        }
        const float* x = ARG_IN(0);
        for (long i = gtid; i < (long)M * DM / 8; i += NGT) { const f32x4 a = ((const f32x4*)x)[2 * i], b = ((const f32x4*)x)[2 * i + 1];
            u32x4 o; o.x = pk2(a[0], a[1]); o.y = pk2(a[2], a[3]); o.z = pk2(b[0], b[1]); o.w = pk2(b[2], b[3]); ((u32x4*)XB)[i] = o; }
        __syncthreads();
    }
    SEAM(0);
    if (IN(1)) { PH_BEGIN
        pg8::Gemm g{XB, Wgu}; pg8::StaticOrder S; S.init(M, 2 * FF, G, bid);
        pg8::EpiSwiGLU E{HM, FF};
        pg8::gemm_phase<pg8::EpiSwiGLU, pg8::StaticOrder, true, true, DM, DM, DM, 0>(lds, g, S, E);
    }
    SEAM(1);
    if (IN(2)) { PH_BEGIN
        pg8::Gemm g{HM, Wd}; pg8::StaticOrder S; S.init(M, DM, G, bid);
        pg8::EpiResF32 E{ARG_IN(0), out, DM, ALPHA, 0.5f};
        pg8::gemm_phase<pg8::EpiResF32, pg8::StaticOrder, true, true, FF, FF, FF, 0>(lds, g, S, E);
    }
    SEAM(2);
    if (IN(3)) { PH_BEGIN
        f32x4 gv[8], bv[8];
#pragma unroll
        for (int j = 0; j < 8; ++j) { gv[j] = ((const f32x4*)ARG_IN(4) + lane)[64 * j]; bv[j] = ((const f32x4*)ARG_IN(5) + lane)[64 * j]; }
        for (int m = gw; m < M; m += NGW) ln_row(out + (size_t)m * DM, gv, bv, nullptr, XB + (size_t)m * DM, ST1 + 2 * (size_t)m, lane);
    }
    SEAM(3);
    if (IN(4)) { PH_BEGIN
        pg8::Gemm g{XB, WinT}; pg8::StaticOrder S; S.init(M, INW, G, bid);
        pg8::EpiBf16Sig E{HM, INW, COL_GA / 256};
        pg8::gemm_phase<pg8::EpiBf16Sig, pg8::StaticOrder, true, true, DM, DM, DM, 0>(lds, g, S, E);
    }
    SEAM(4);
    if (IN(5)) { PH_BEGIN
        for (int u = bid; u < (SEQ / 64) * NKVH; u += G) att::attn_unit((LAS char*)lds, HM, ARG_IN(7), u & 3, u >> 2);
        for (int w = gw; w < 2048; w += NGW) { const int g = w & 3, tb = 2 * (w >> 2) + (lane >> 5), c8 = 32 * g + (lane & 31);
            if (g == 0) pool_item<1>(HM, Dp, tb, c8); else if (g == 1) pool_item<2>(HM, Dp, tb, c8); else if (g == 2) pool_item<4>(HM, Dp, tb, c8); else pool_item<8>(HM, Dp, tb, c8); }
        __syncthreads();
    }
    SEAM(5);
    if (IN(6)) { PH_BEGIN
        pg8::Gemm g{Dp, WgT}; pg8::StaticOrder S; S.init(M, 1024, G, bid);
        pg8::EpiColScale E{Pm, 1024, ARG_IN(9)};
        pg8::gemm_phase<pg8::EpiColScale, pg8::StaticOrder, true, true, 256, 1024, 256, 256>(lds, g, S, E);
    }
    SEAM(6);
    if (IN(7)) { PH_BEGIN
        {   pg8::Gemm g{HM, WpaT}; pg8::StaticOrder S; S.init(M, DM, G, bid);
            pg8::EpiGate<false> E{XB, DM, HM + COL_GA, INW};
            pg8::gemm_phase<pg8::EpiGate<false>, pg8::StaticOrder, true, true, DM, INW, DM, 0>(lds, g, S, E); }
        {   pg8::Gemm g{Pm, WppT}; pg8::StaticOrder S; S.init(M, DM, G, bid);
            pg8::EpiGate<true> E{XB, DM, HM + COL_GB, INW};
            pg8::gemm_phase<pg8::EpiGate<true>, pg8::StaticOrder, true, true, 1024, 1024, 1024, 0>(lds, g, S, E); }
    }
    SEAM(7);
    if (IN(8)) { PH_BEGIN
        pg8::Gemm g{XB, WoutT}; pg8::StaticOrder S; S.init(M, DM, G, bid);
        pg8::EpiResLN E{out, ST1, ARG_IN(4), ARG_IN(5), Z2, DM, ALPHA, 1.0f};
        pg8::gemm_phase<pg8::EpiResLN, pg8::StaticOrder, true, true, DM, DM, DM, 0>(lds, g, S, E);
    }
    SEAM(8);
    if (IN(9)) { PH_BEGIN
        {   f32x4 gv[8], bv[8];
#pragma unroll
            for (int j = 0; j < 8; ++j) { gv[j] = ((const f32x4*)ARG_IN(13) + lane)[64 * j]; bv[j] = ((const f32x4*)ARG_IN(14) + lane)[64 * j]; }
            for (int m = gw; m < M; m += NGW) ln_row(Z2 + (size_t)m * DM, gv, bv, nullptr, XB + (size_t)m * DM, ST2 + 2 * (size_t)m, lane); }
        {   int base = 0;
            base = run_tr(ARG_IN(15), Wgu, DM, FF, 1, 0, base, gw, NGW, scr, lane);
            base = run_tr(ARG_IN(16), Wgu, DM, FF, 2, 0, base, gw, NGW, scr, lane);
            base = run_tr(ARG_IN(17), Wd, FF, DM, 0, 0, base, gw, NGW, scr, lane); }
        __syncthreads();
    }
    SEAM(9);
    if (IN(10)) { PH_BEGIN
        pg8::Gemm g{XB, Wgu}; pg8::StaticOrder S; S.init(M, 2 * FF, G, bid);
        pg8::EpiSwiGLU E{HM, FF};
        pg8::gemm_phase<pg8::EpiSwiGLU, pg8::StaticOrder, true, true, DM, DM, DM, 0>(lds, g, S, E);
    }
    SEAM(10);
    if (IN(11)) { PH_BEGIN
        pg8::Gemm g{HM, Wd}; pg8::StaticOrder S; S.init(M, DM, G, bid);
        pg8::EpiResLN E{Z2, ST2, ARG_IN(13), ARG_IN(14), out, DM, ALPHA, 0.5f};
        pg8::gemm_phase<pg8::EpiResLN, pg8::StaticOrder, true, true, FF, FF, FF, 0>(lds, g, S, E);
    }
    SEAM(11);
    if (IN(12)) { PH_BEGIN
        f32x4 gv[8], bv[8];
#pragma unroll
        for (int j = 0; j < 8; ++j) { gv[j] = ((const f32x4*)ARG_IN(18) + lane)[64 * j]; bv[j] = ((const f32x4*)ARG_IN(19) + lane)[64 * j]; }
        for (int m = gw; m < M; m += NGW) ln_row(out + (size_t)m * DM, gv, bv, out + (size_t)m * DM, nullptr, nullptr, lane);
    }
#if PROBE_MASK
    STAMP(12);
    if (blockIdx.x == 0 && threadIdx.x == 0) { unsigned long long sum = 0;
        for (int k = 0; k < N_PHASES; ++k) if ((PROBE_MASK >> k) & 1) sum += *(LAS unsigned long long*)(lds + 146432 + 8 * (k + 1)) - *(LAS unsigned long long*)(lds + 146432 + 8 * k);
        const unsigned long long t0 = __builtin_amdgcn_s_memrealtime(); while (__builtin_amdgcn_s_memrealtime() - t0 < sum) __builtin_amdgcn_s_sleep(8); }
#endif
#undef IN
#undef SEAM
#undef PH_BEGIN
}

#ifndef MK_PER_PHASE
#define MK_PER_PHASE 0
#endif
extern "C" void kernel_launch(void* const* d_in, const int* in_sizes, int n_in, void* d_out, int out_size, void* d_ws, size_t ws_size, hipStream_t stream) {
    static int grid = 0;
    if (grid == 0) {
        if (n_in != 20 || in_sizes[0] != M * DM || out_size != M * DM || ws_size < WS_END) {
            fprintf(stderr, "kernel_launch: unexpected shapes: n_in %d in0 %d out %d ws %zu (need %zu)\n", n_in, n_in > 0 ? in_sizes[0] : -1, out_size, ws_size, (size_t)WS_END); grid = -1; return; }
        int dev = 0, cus = 0, per_cu = 0;
        hipGetDevice(&dev); hipDeviceGetAttribute(&cus, hipDeviceAttributeMultiprocessorCount, dev);
        if (hipFuncSetAttribute((const void*)fwd_mega, hipFuncAttributeMaxDynamicSharedMemorySize, LDS_BYTES) != hipSuccess) { fprintf(stderr, "kernel_launch: hipFuncSetAttribute failed\n"); grid = -1; return; }
        if (hipOccupancyMaxActiveBlocksPerMultiprocessor(&per_cu, (const void*)fwd_mega, NTHREADS, LDS_BYTES) != hipSuccess || per_cu < 1) { fprintf(stderr, "kernel_launch: occupancy query says %d\n", per_cu); per_cu = 1; }
        (void)hipGetLastError();
        grid = cus * 1;
    }
    if (grid < 0) return;
    Args a{};
    for (int i = 0; i < 20; ++i) a.in[i] = (const float*)d_in[i];
    a.out = (float*)d_out; a.ws = (unsigned char*)d_ws;
#if MK_PER_PHASE
    for (int p = 0; p < N_PHASES; ++p) { a.ph_lo = p; a.ph_hi = p + 1; hipLaunchKernelGGL(fwd_mega, dim3(grid), dim3(NTHREADS), LDS_BYTES, stream, a); }
#else
    a.ph_lo = 0; a.ph_hi = N_PHASES;
    void* kargs[] = {&a};
    hipError_t e = hipLaunchCooperativeKernel((const void*)fwd_mega, dim3(grid), dim3(NTHREADS), kargs, LDS_BYTES, stream);
    if (e != hipSuccess) fprintf(stderr, "kernel_launch: cooperative launch failed: %s (grid %d)\n", hipGetErrorString(e), grid);
#endif
}
```
